# Optimizing an MI355X kernel written in HIP

```python
import math
import jax, jax.numpy as jnp
from jax import lax
import numpy as np

D_MODEL = 4096
BATCH = 8
SEQ = 2048
DEPTH = 1
DEC_BATCH = 2
DEC_SEQ = 4096
PAST_LEN = 128

SSM_WIDTH = 2048
SSM_GROUP = 16
SSM_GROUPS = SSM_WIDTH // SSM_GROUP
SSM_STATE = 64
N_DIR = 2
DT_MIN = 1e-3
DT_MAX = 1e-1
LAMBDA_RE_MAX = -1e-4
FFT_WIDTH = 2048
FFT_GROUPS = 4
FFT_GROUP = FFT_WIDTH // FFT_GROUPS
N_BRANCH = 2
IN_WIDTH = 2 * SSM_WIDTH + 2 * FFT_WIDTH + N_BRANCH * D_MODEL
RMS_EPS = 1e-6

kernel_name = "hybrid_s5_fnet_gated_encoder"


def _rmsnorm(x, g):
    xf = x.astype(jnp.float32)
    y = xf * lax.rsqrt(jnp.mean(xf * xf, axis=-1, keepdims=True) + RMS_EPS)
    return (y * g.astype(jnp.float32)).astype(x.dtype)


def _ssm_combine(e1, e2):
    a1, b1 = e1
    a2, b2 = e2
    return a1 * a2, a2 * b1 + b2


def _s5_direction(u, lam_re, lam_im, log_dt, b_re, b_im, c_re, c_im, reverse):
    f32 = jnp.float32
    lam = lax.complex(jnp.minimum(lam_re.astype(f32), LAMBDA_RE_MAX), lam_im.astype(f32))
    dt = jnp.exp(log_dt.astype(f32))[:, None]
    lam_bar = jnp.exp(lam * dt)
    b_bar = ((lam_bar - 1.0) / lam)[..., None] * lax.complex(b_re.astype(f32), b_im.astype(f32))
    c_mat = lax.complex(c_re.astype(f32), c_im.astype(f32))
    bu = jnp.einsum('blgc,gpc->blgp', u.astype(jnp.complex64), b_bar)
    a = jnp.broadcast_to(lam_bar, bu.shape)
    _, states = lax.associative_scan(_ssm_combine, (a, bu), reverse=reverse, axis=1)
    return jnp.einsum('blgp,gcp->blgc', states, c_mat).real


def _s5_bidirectional(u, lam_re, lam_im, log_dt, b_re, b_im, c_re, c_im, d_skip):
    bsz, seq, _ = u.shape
    ug = u.astype(jnp.float32).reshape(bsz, seq, SSM_GROUPS, SSM_GROUP)
    y_fwd = _s5_direction(ug, lam_re[0], lam_im[0], log_dt[0], b_re[0], b_im[0], c_re[0], c_im[0], False)
    y_bwd = _s5_direction(ug, lam_re[1], lam_im[1], log_dt[1], b_re[1], b_im[1], c_re[1], c_im[1], True)
    y = y_fwd + y_bwd + d_skip.astype(jnp.float32).reshape(SSM_GROUPS, SSM_GROUP) * ug
    return y.reshape(bsz, seq, SSM_WIDTH)


def _fourier_mix(u, w_fft):
    bsz, seq, _ = u.shape
    ug = u.astype(jnp.float32).reshape(bsz, seq, FFT_GROUPS, FFT_GROUP)
    f = jnp.fft.fft2(ug, axes=(1, 3), norm="ortho").real
    y = jnp.einsum('blgc,gcd->blgd', f, w_fft.astype(jnp.float32))
    return y.reshape(bsz, seq, FFT_WIDTH)


def _layer(x, pre_g, post_g, w_in, lam_re, lam_im, log_dt, b_re, b_im, c_re, c_im, d_skip,
           w_glu, w_fft, w_up_ssm, w_up_fft, w_out):
    dt = x.dtype
    h = _rmsnorm(x, pre_g)
    proj = h @ w_in
    s1 = SSM_WIDTH
    s2 = 2 * SSM_WIDTH
    s3 = s2 + FFT_WIDTH
    s4 = s3 + FFT_WIDTH
    u_ssm, z_ssm, u_fft, z_fft, gate_logits = jnp.split(proj, [s1, s2, s3, s4], axis=-1)
    y_ssm = jax.nn.gelu(_s5_bidirectional(u_ssm, lam_re, lam_im, log_dt, b_re, b_im, c_re, c_im, d_skip)).astype(dt)
    glu_val, glu_gate = jnp.split(y_ssm @ w_glu, 2, axis=-1)
    y_ssm = glu_val * jax.nn.sigmoid(glu_gate) * jax.nn.silu(z_ssm)
    y_fft = _fourier_mix(u_fft, w_fft).astype(dt) * jax.nn.silu(z_fft)
    p_ssm = y_ssm @ w_up_ssm
    p_fft = y_fft @ w_up_fft
    g = jax.nn.sigmoid(gate_logits).reshape(*gate_logits.shape[:-1], N_BRANCH, D_MODEL)
    merged = g[..., 0, :] * p_ssm + g[..., 1, :] * p_fft
    out = merged @ w_out
    return x + _rmsnorm(out, post_g)


def _trunk(x, pre_norm, post_norm, w_in, lambda_re, lambda_im, log_dt, b_re, b_im, c_re, c_im,
           d_skip, w_glu, w_fft, w_up_ssm, w_up_fft, w_out):
    for l in range(DEPTH):
        x = _layer(x, pre_norm[l], post_norm[l], w_in[l], lambda_re[l], lambda_im[l], log_dt[l],
                   b_re[l], b_im[l], c_re[l], c_im[l], d_skip[l], w_glu[l], w_fft[l],
                   w_up_ssm[l], w_up_fft[l], w_out[l])
    return x


def setup_inputs(seed: int = 0) -> dict:
    key = jax.random.key(seed)
    ks = jax.random.split(key, 20)
    f32 = jnp.float32
    G, P, C = SSM_GROUPS, SSM_STATE, SSM_GROUP
    nrm = lambda k, shape, scale: jax.random.normal(k, shape, f32) * scale
    x_prompt = jax.random.normal(ks[0], (BATCH, SEQ, D_MODEL), f32)
    x_sample = jax.random.normal(ks[1], (DEC_BATCH, DEC_SEQ, D_MODEL), f32)
    pre_norm = 1.0 + nrm(ks[2], (DEPTH, D_MODEL), 0.05)
    post_norm = 1.0 + nrm(ks[3], (DEPTH, D_MODEL), 0.05)
    w_in = nrm(ks[4], (DEPTH, D_MODEL, IN_WIDTH), D_MODEL ** -0.5)
    lambda_re = -0.5 + nrm(ks[5], (DEPTH, N_DIR, G, P), 0.01)
    lambda_im = jnp.pi * jnp.arange(P, dtype=f32) + nrm(ks[6], (DEPTH, N_DIR, G, P), 0.01)
    log_dt = jax.random.uniform(ks[7], (DEPTH, N_DIR, G), f32, math.log(DT_MIN), math.log(DT_MAX))
    b_re = nrm(ks[8], (DEPTH, N_DIR, G, P, C), (2.0 * C) ** -0.5)
    b_im = nrm(ks[9], (DEPTH, N_DIR, G, P, C), (2.0 * C) ** -0.5)
    c_re = nrm(ks[10], (DEPTH, N_DIR, G, C, P), (2.0 * P) ** -0.5)
    c_im = nrm(ks[11], (DEPTH, N_DIR, G, C, P), (2.0 * P) ** -0.5)
    d_skip = nrm(ks[12], (DEPTH, SSM_WIDTH), 1.0)
    w_glu = nrm(ks[13], (DEPTH, SSM_WIDTH, 2 * SSM_WIDTH), SSM_WIDTH ** -0.5)
    w_fft = nrm(ks[14], (DEPTH, FFT_GROUPS, FFT_GROUP, FFT_GROUP), FFT_GROUP ** -0.5)
    w_up_ssm = nrm(ks[15], (DEPTH, SSM_WIDTH, D_MODEL), SSM_WIDTH ** -0.5)
    w_up_fft = nrm(ks[16], (DEPTH, FFT_WIDTH, D_MODEL), FFT_WIDTH ** -0.5)
    w_out = nrm(ks[17], (DEPTH, D_MODEL, D_MODEL), D_MODEL ** -0.5)
    return {"x_prompt": x_prompt, "x_sample": x_sample, "pre_norm": pre_norm, "post_norm": post_norm,
            "w_in": w_in, "lambda_re": lambda_re, "lambda_im": lambda_im, "log_dt": log_dt,
            "b_re": b_re, "b_im": b_im, "c_re": c_re, "c_im": c_im, "d_skip": d_skip,
            "w_glu": w_glu, "w_fft": w_fft, "w_up_ssm": w_up_ssm, "w_up_fft": w_up_fft, "w_out": w_out}


def reference(x_prompt, x_sample, pre_norm, post_norm, w_in, lambda_re, lambda_im, log_dt,
              b_re, b_im, c_re, c_im, d_skip, w_glu, w_fft, w_up_ssm, w_up_fft, w_out):
    y_prompt = _trunk(x_prompt, pre_norm, post_norm, w_in, lambda_re, lambda_im, log_dt, b_re, b_im,
                      c_re, c_im, d_skip, w_glu, w_fft, w_up_ssm, w_up_fft, w_out)
    y_sample = _trunk(x_sample, pre_norm, post_norm, w_in, lambda_re, lambda_im, log_dt, b_re, b_im,
                      c_re, c_im, d_skip, w_glu, w_fft, w_up_ssm, w_up_fft, w_out)
    return (y_prompt, y_sample)
```

```cpp
#define MK_N_LAUNCHES 1
#include <hip/hip_runtime.h>
#include <cstdio>
#include <cstdint>

#define GAS __attribute__((address_space(1)))
#define LAS __attribute__((address_space(3)))
typedef unsigned short bf16_t;
typedef short bf16x8 __attribute__((ext_vector_type(8)));
typedef float f32x4 __attribute__((ext_vector_type(4)));
typedef float f32x2 __attribute__((ext_vector_type(2)));
typedef unsigned u32x4 __attribute__((ext_vector_type(4)));
typedef unsigned u32x2 __attribute__((ext_vector_type(2)));

namespace gp {
constexpr int BM = 256, BK = 64, HALF = 128, HTB = HALF * BK * 2  , STAGE_BYTES = 8 * HTB;

__host__ __device__ __forceinline__ int lds_byte(int r, int c) { const int st = (r >> 4) * 2 + (c >> 5), rr = r & 15, cc = c & 31, ob = rr * 64 + cc * 2; return st * 1024 + (ob ^ (((ob >> 9) & 1) << 5)); }
__host__ __device__ __forceinline__ void stage_rc(int b, int& R, int& C) { const int st = b / 1024, sb = b % 1024, swz = sb ^ (((sb >> 9) & 1) << 5); R = (st >> 1) * 16 + swz / 64; C = (st & 1) * 32 + (swz % 64) / 2; }
__host__ __device__ __forceinline__ int perm32(int rho) { const int n = rho >> 4, i = rho & 15; return 8 * (i >> 2) + 4 * n + (i & 3); }

struct SU { const char* A; const char* B; int nt; int flags; int pm; int pn; };
enum { F_EPI = 1, F_ZERO = 2, F_SEG1 = 4 };

struct RowMajor { static constexpr int AUX = 0; int ld; __device__ __forceinline__ unsigned off(int R, int C) const { return (unsigned)(R * ld + C) * 2u; }
    __device__ __forceinline__ size_t kstep() const { return (size_t)BK * 2; } __device__ __forceinline__ size_t hstep() const { return (size_t)HALF * ld * 2; } };
struct GroupMajor { static constexpr int AUX = 0; int rows; __device__ __forceinline__ unsigned off(int R, int C) const { return (unsigned)(C >> 4) * (unsigned)(rows * 32) + (unsigned)(R * 32 + (C & 15) * 2); }
    __device__ __forceinline__ size_t kstep() const { return (size_t)4 * rows * 32; } __device__ __forceinline__ size_t hstep() const { return (size_t)HALF * 32; } };

typedef __bf16 bf16x2_t __attribute__((ext_vector_type(2)));
__device__ __forceinline__ unsigned cvt_pk_bf16(float lo, float hi) { const f32x2 v = {lo, hi}; return __builtin_bit_cast(unsigned, __builtin_convertvector(v, bf16x2_t)); }
__device__ __forceinline__ u32x4 pack8(const f32x4 a, const f32x4 b) { u32x4 w; w.x = cvt_pk_bf16(a[0], a[1]); w.y = cvt_pk_bf16(a[2], a[3]); w.z = cvt_pk_bf16(b[0], b[1]); w.w = cvt_pk_bf16(b[2], b[3]); return w; }
__device__ __forceinline__ float bf_lo(unsigned w) { return __uint_as_float(w << 16); }
__device__ __forceinline__ float bf_hi(unsigned w) { return __uint_as_float(w & 0xffff0000u); }
__device__ __forceinline__ void unpack8(const u32x4 w, f32x4& a, f32x4& b) { a = (f32x4){bf_lo(w.x), bf_hi(w.x), bf_lo(w.y), bf_hi(w.y)}; b = (f32x4){bf_lo(w.z), bf_hi(w.z), bf_lo(w.w), bf_hi(w.w)}; }
__device__ __forceinline__ float sigmoidf_(float x) { return __builtin_amdgcn_rcpf(1.0f + __builtin_amdgcn_exp2f(-1.44269504089f * x)); }
__device__ __forceinline__ float siluf_(float x) { return x * sigmoidf_(x); }
__device__ __forceinline__ float gelu_tanh_(float x) { const float z = x + 0.044715f * x * x * x; return x * __builtin_amdgcn_rcpf(1.0f + __builtin_amdgcn_exp2f(-2.30220819813f * z)); }
__device__ __forceinline__ void sigmoid2_(float a, float b, float& sa, float& sb) {
    const float ea = 1.0f + fminf(__builtin_amdgcn_exp2f(-1.44269504089f * a), 1e18f), eb = 1.0f + fminf(__builtin_amdgcn_exp2f(-1.44269504089f * b), 1e18f);
    const float ip = __builtin_amdgcn_rcpf(ea * eb); sa = ip * eb; sb = ip * ea; }
template <int ACT> __device__ __forceinline__ f32x4 act4(f32x4 v) {
    if (ACT == 1) { float s0, s1, s2, s3; sigmoid2_(v[0], v[1], s0, s1); sigmoid2_(v[2], v[3], s2, s3); return v * (f32x4){s0, s1, s2, s3}; }
    if (ACT == 2) { float s0, s1, s2, s3; sigmoid2_(v[0], v[1], s0, s1); sigmoid2_(v[2], v[3], s2, s3); return (f32x4){s0, s1, s2, s3}; }
    if (ACT == 3) { return (f32x4){gelu_tanh_(v[0]), gelu_tanh_(v[1]), gelu_tanh_(v[2]), gelu_tanh_(v[3])}; }
    return v;
}
__device__ __forceinline__ unsigned opaque_u(unsigned v) { asm volatile("" : "+v"(v)); return v; }
template <int ACT> __device__ __forceinline__ void store_tile(const f32x4 (&acc)[2][2][4][2], bf16_t* O, unsigned ld, int wr, int wc, int fr, int fq) {
    const unsigned lo = opaque_u((unsigned)(wr * 64 + fr) * ld + (unsigned)(wc * 32 + 8 * fq));
#pragma unroll
    for (int ai = 0; ai < 2; ++ai)
#pragma unroll
        for (int m = 0; m < 4; ++m) { bf16_t* rowp = O + (size_t)(ai * HALF + m * 16) * ld;
#pragma unroll
            for (int bj = 0; bj < 2; ++bj) *(u32x4*)(rowp + bj * HALF + lo) = pack8(act4<ACT>(acc[ai][bj][m][0]), act4<ACT>(acc[ai][bj][m][1])); }
}

template <class AddrA, class AddrB, class Sched, class Epi, bool ALIGN_EPI, bool SP2>
__device__ __forceinline__ void gemm_phase(LAS unsigned char* lds, const AddrA aA, const AddrB aB, const Sched& S, const Epi& E) {
    int tid_ = threadIdx.x; asm volatile("" : "+v"(tid_));
    const int tid = tid_, wid = __builtin_amdgcn_readfirstlane(tid >> 6), lane = tid & 63, wr = wid >> 2, wc = wid & 3, fr = lane & 15, fq = lane >> 4;
    unsigned voffA[2], voffB[2];
#pragma unroll
    for (int i = 0; i < 2; ++i) { int R, C; stage_rc(tid * 16 + i * 8192, R, C); const int Rb = (R & ~31) + perm32(R & 31);
        voffA[i] = aA.off(R, C); voffB[i] = aB.off(Rb, C); }
    const size_t kstepA = aA.kstep(), kstepB = aB.kstep(), hstepA = aA.hstep(), hstepB = aB.hstep();
    const unsigned ldsw = (unsigned)wid * 1024u;
    const int aoff = lds_byte(wr * 64 + fr, fq * 8), boff = lds_byte(wc * 32 + fr, fq * 8);
#define PG8_SA(b, h) (((b) * 2 + (h)) * HTB)
#define PG8_SB(b, h) ((4 + (b) * 2 + (h)) * HTB)
#define PG8_STAGE(bufoff, gbase, voff) do { _Pragma("unroll") for (int _i = 0; _i < 2; ++_i) \
        __builtin_amdgcn_global_load_lds((const unsigned*)((const char*)(gbase) + (voff)[_i]), (LAS unsigned*)(lds + (bufoff) + ldsw + _i * 8192), 16, 0, 0); } while (0)
#define PG8_STAGEB(bufoff, gbase, voff) do { _Pragma("unroll") for (int _i = 0; _i < 2; ++_i) \
        __builtin_amdgcn_global_load_lds((const unsigned*)((const char*)(gbase) + (voff)[_i]), (LAS unsigned*)(lds + (bufoff) + ldsw + _i * 8192), 16, 0, AddrB::AUX); } while (0)
#define PG8_LDA(dst, b, h) do { _Pragma("unroll") for (int m = 0; m < 4; ++m) _Pragma("unroll") for (int k = 0; k < 2; ++k) dst[m][k] = *(const LAS bf16x8*)(lds + PG8_SA(b, h) + aoff + m * 2048 + k * 1024); } while (0)
#define PG8_LDB(dst, b, h) do { _Pragma("unroll") for (int n = 0; n < 2; ++n) _Pragma("unroll") for (int k = 0; k < 2; ++k) dst[n][k] = *(const LAS bf16x8*)(lds + PG8_SB(b, h) + boff + n * 2048 + k * 1024); } while (0)
#define PG8_MMA(ai, bj, At, Bt) do { __builtin_amdgcn_s_setprio(1); _Pragma("unroll") for (int m = 0; m < 4; ++m) _Pragma("unroll") for (int n = 0; n < 2; ++n) _Pragma("unroll") for (int k = 0; k < 2; ++k) \
        acc[ai][bj][m][n] = __builtin_amdgcn_mfma_f32_16x16x32_bf16(Bt[n][k], At[m][k], acc[ai][bj][m][n], 0, 0, 0); __builtin_amdgcn_s_setprio(0); } while (0)
#define PG8_WAIT_V(n) asm volatile("s_waitcnt vmcnt(" #n ")" ::: "memory")
#define PG8_WAIT_L(n) asm volatile("s_waitcnt lgkmcnt(" #n ")" ::: "memory")
#define PG8_BAR __builtin_amdgcn_s_barrier()
#define PG8_SCHED __builtin_amdgcn_sched_barrier(0)
    SU cur, nxt; int ui = 0;
    if (!S.next(0, cur)) return;
    f32x4 acc[2][2][4][2];
#pragma unroll
    for (int a = 0; a < 2; ++a)
#pragma unroll
        for (int b = 0; b < 2; ++b)
#pragma unroll
            for (int m = 0; m < 4; ++m)
#pragma unroll
                for (int n = 0; n < 2; ++n) acc[a][b][m][n] = (f32x4){0.f, 0.f, 0.f, 0.f};
    bf16x8 At[4][2], B0[2][2], B1[2][2];
    const char* cA = cur.A; const char* cB = cur.B;
    if constexpr (SP2) {
        PG8_STAGEB(PG8_SB(0, 0), cB, voffB); PG8_STAGEB(PG8_SB(0, 1), cB + hstepB, voffB); PG8_STAGE(PG8_SA(0, 0), cA, voffA); PG8_STAGE(PG8_SA(0, 1), cA + hstepA, voffA);
        if (wr == 1) PG8_BAR;
        PG8_WAIT_V(2); PG8_BAR;
        PG8_STAGEB(PG8_SB(1, 0), cB + kstepB, voffB); PG8_STAGE(PG8_SA(1, 0), cA + kstepA, voffA); PG8_STAGEB(PG8_SB(1, 1), cB + hstepB + kstepB, voffB);
        PG8_WAIT_V(6); PG8_BAR;
    } else {
        PG8_STAGEB(PG8_SB(0, 0), cB, voffB); PG8_STAGE(PG8_SA(0, 0), cA, voffA); PG8_STAGEB(PG8_SB(0, 1), cB + hstepB, voffB); PG8_STAGE(PG8_SA(0, 1), cA + hstepA, voffA);
        if (wr == 1) PG8_BAR;
        PG8_WAIT_V(4); PG8_BAR;
        PG8_STAGEB(PG8_SB(1, 0), cB + kstepB, voffB); PG8_STAGE(PG8_SA(1, 0), cA + kstepA, voffA); PG8_STAGEB(PG8_SB(1, 1), cB + hstepB + kstepB, voffB);
        PG8_WAIT_V(6); PG8_BAR;
    }
    for (;;) {
        const bool has_next = S.next(ui + 1, nxt);
        const char* nA = has_next ? nxt.A : cA; const char* nB = has_next ? nxt.B : cB;
        int nt = cur.nt; asm volatile("" : "+s"(nt));
        for (int t = 0; t < nt; t += 2) {
            const bool last = (t == nt - 2);
            const char* a1 = cA + (size_t)(t + 1) * kstepA;
            const char* a2 = last ? nA : cA + (size_t)(t + 2) * kstepA; const char* b2 = last ? nB : cB + (size_t)(t + 2) * kstepB;
            const char* a3 = a2 + kstepA; const char* b3 = b2 + kstepB;
            if constexpr (SP2) {
            PG8_LDB(B0, 0, 0); PG8_LDB(B1, 0, 1); PG8_SCHED; PG8_LDA(At, 0, 0); PG8_STAGE(PG8_SA(1, 1), a1 + hstepA, voffA);
            PG8_WAIT_V(8); PG8_WAIT_L(0); PG8_BAR; PG8_MMA(0, 0, At, B0); PG8_MMA(0, 1, At, B1); PG8_BAR; PG8_SCHED;
            PG8_LDA(At, 0, 1); PG8_STAGEB(PG8_SB(0, 0), b2, voffB); PG8_STAGEB(PG8_SB(0, 1), b2 + hstepB, voffB); PG8_STAGE(PG8_SA(0, 0), a2, voffA);
            PG8_WAIT_V(8); PG8_WAIT_L(0); PG8_BAR; PG8_MMA(1, 0, At, B0); PG8_MMA(1, 1, At, B1); PG8_BAR; PG8_SCHED;
            PG8_LDB(B0, 1, 0); PG8_LDB(B1, 1, 1); PG8_SCHED; PG8_LDA(At, 1, 0); PG8_STAGE(PG8_SA(0, 1), a2 + hstepA, voffA);
            PG8_WAIT_V(8); PG8_WAIT_L(0); PG8_BAR; PG8_MMA(0, 0, At, B0); PG8_MMA(0, 1, At, B1); PG8_BAR; PG8_SCHED;
            PG8_LDA(At, 1, 1); PG8_STAGEB(PG8_SB(1, 0), b3, voffB); PG8_STAGEB(PG8_SB(1, 1), b3 + hstepB, voffB); PG8_STAGE(PG8_SA(1, 0), a3, voffA);
            PG8_WAIT_V(8); PG8_WAIT_L(0); PG8_BAR; PG8_MMA(1, 0, At, B0); PG8_MMA(1, 1, At, B1); PG8_BAR; PG8_SCHED;
            } else {
            PG8_LDB(B0, 0, 0); PG8_SCHED; PG8_LDA(At, 0, 0); PG8_STAGE(PG8_SA(1, 1), a1 + hstepA, voffA);
            PG8_WAIT_L(8); PG8_BAR; PG8_WAIT_L(0); PG8_MMA(0, 0, At, B0); PG8_BAR; PG8_SCHED;
            PG8_LDB(B1, 0, 1); PG8_STAGEB(PG8_SB(0, 0), b2, voffB);
            PG8_BAR; PG8_WAIT_L(0); PG8_MMA(0, 1, At, B1); PG8_BAR;
            PG8_LDA(At, 0, 1); PG8_STAGE(PG8_SA(0, 0), a2, voffA);
            PG8_BAR; PG8_WAIT_L(0); PG8_MMA(1, 0, At, B0); PG8_BAR; PG8_SCHED;
            PG8_STAGEB(PG8_SB(0, 1), b2 + hstepB, voffB);
            PG8_WAIT_V(6); PG8_BAR; PG8_MMA(1, 1, At, B1); PG8_BAR;
            PG8_LDB(B0, 1, 0); PG8_SCHED; PG8_LDA(At, 1, 0); PG8_STAGE(PG8_SA(0, 1), a2 + hstepA, voffA);
            PG8_WAIT_L(8); PG8_BAR; PG8_WAIT_L(0); PG8_MMA(0, 0, At, B0); PG8_BAR; PG8_SCHED;
            PG8_LDB(B1, 1, 1); PG8_STAGEB(PG8_SB(1, 0), b3, voffB);
            PG8_BAR; PG8_WAIT_L(0); PG8_MMA(0, 1, At, B1); PG8_BAR;
            PG8_LDA(At, 1, 1); PG8_STAGE(PG8_SA(1, 0), a3, voffA);
            PG8_BAR; PG8_WAIT_L(0); PG8_MMA(1, 0, At, B0); PG8_BAR; PG8_SCHED;
            PG8_STAGEB(PG8_SB(1, 1), b3 + hstepB, voffB);
            PG8_WAIT_V(6); PG8_BAR; PG8_MMA(1, 1, At, B1); PG8_BAR;
            }
        }
        const bool epi = (cur.flags & F_EPI) != 0;
        if (epi) { if constexpr (ALIGN_EPI) { if (wr == 0) PG8_BAR; }
            E(acc, cur, wr, wc, fr, fq); }
        if (!has_next) break;
        if (cur.flags & F_ZERO) {
#pragma unroll
            for (int a = 0; a < 2; ++a)
#pragma unroll
                for (int b = 0; b < 2; ++b)
#pragma unroll
                    for (int m = 0; m < 4; ++m)
#pragma unroll
                        for (int n = 0; n < 2; ++n) acc[a][b][m][n] = (f32x4){0.f, 0.f, 0.f, 0.f};
        }
        cur = nxt; cA = nA; cB = nB; ++ui;
        if constexpr (ALIGN_EPI) { if (epi && wr == 1) PG8_BAR; }
    }
    PG8_WAIT_V(0);
    if constexpr (!ALIGN_EPI) { if (wr == 0) PG8_BAR; }
    PG8_BAR;
#undef PG8_SA
#undef PG8_SB
#undef PG8_STAGE
#undef PG8_STAGEB
#undef PG8_LDA
#undef PG8_LDB
#undef PG8_MMA
#undef PG8_WAIT_V
#undef PG8_WAIT_L
#undef PG8_BAR
#undef PG8_SCHED
}
}
#define XB_TMO      128
#define XB_XCNT(j)  (256  + 64 * (j))
#define XB_XSUB(j)  (1280 + 64 * (j))
#define XB_XGEN(j)  (2304 + 64 * (j))
#define XB_TOP      3328
#define XB_TOPGEN   3392
#define XCD_BAR_WORDS 3456
#define XB_SPIN_CAP (1u << 18)

__device__ __forceinline__ unsigned xb_ld(unsigned* p)              { return __hip_atomic_load(p, __ATOMIC_RELAXED, __HIP_MEMORY_SCOPE_AGENT); }
__device__ __forceinline__ unsigned xb_add(unsigned* p, unsigned v) { return __hip_atomic_fetch_add(p, v, __ATOMIC_RELAXED, __HIP_MEMORY_SCOPE_AGENT); }
__device__ __forceinline__ unsigned xb_xcc_id() { return (unsigned)__builtin_amdgcn_s_getreg((3 << 11) | 20) & 0xFu; }
#define XB_SPIN(cond, bar) do { unsigned _sp = 0; while (cond) { __builtin_amdgcn_s_sleep(1); \
    if ((++_sp & 255u) == 0u) { if (xb_ld(&(bar)[XB_TMO])) break; if (_sp > XB_SPIN_CAP) { atomicAdd(&(bar)[XB_TMO], 1u); break; } } } } while (0)

struct XcdBarrier {
    unsigned* bar; unsigned x;
    volatile LAS unsigned* st;
};

__device__ __forceinline__ XcdBarrier xcd_barrier_post(unsigned* bar, volatile LAS unsigned* st) {
    XcdBarrier b; b.bar = bar; b.x = xb_xcc_id(); b.st = st;
    if (threadIdx.x == 0) (void)xb_add(&bar[XB_XCNT(b.x)], 1u);
    return b;
}
__device__ __forceinline__ void xcd_barrier_complete(unsigned* bar, unsigned x, unsigned& nloc, unsigned& nx) {
    const unsigned G = gridDim.x * gridDim.y * gridDim.z;
    unsigned sum, cnt, mine, sp = 0u;
    for (;;) {
        sum = 0u; cnt = 0u; mine = 0u;
#pragma unroll
        for (unsigned j = 0; j < 16; ++j) { const unsigned c = xb_ld(&bar[XB_XCNT(j)]); sum += c; cnt += (c > 0u) ? 1u : 0u; mine = (j == x) ? c : mine; }
        if (sum == G) break;
        __builtin_amdgcn_s_sleep(1);
        if ((++sp & 255u) == 0u) { if (xb_ld(&bar[XB_TMO])) break; if (sp > XB_SPIN_CAP) { atomicAdd(&bar[XB_TMO], 1u); break; } }
    }
    nloc = mine > 0u ? mine : 1u; nx = cnt > 0u ? cnt : 1u;
}

__device__ __forceinline__ void xcd_barrier(const XcdBarrier& b) {
    asm volatile("s_waitcnt vmcnt(0)" ::: "memory");
    __syncthreads();
    if (threadIdx.x == 0) {
        unsigned* bar = b.bar;
        __builtin_amdgcn_s_waitcnt(0);
        unsigned nloc = b.st[0], nx = b.st[1];
        if (nloc == 0u) { xcd_barrier_complete(bar, b.x, nloc, nx); b.st[0] = nloc; b.st[1] = nx; }
        const unsigned old = xb_add(&bar[XB_XSUB(b.x)], 1u);
        const unsigned gen = old / nloc;
        if (old + 1u == (gen + 1u) * nloc) {
            __builtin_amdgcn_fence(__ATOMIC_RELEASE, "agent");
            asm volatile("s_waitcnt vmcnt(0)" ::: "memory");
            const unsigned og = xb_add(&bar[XB_TOP], 1u);
            const unsigned tg = og / nx;
            if (og + 1u == (tg + 1u) * nx) xb_add(&bar[XB_TOPGEN], 1u);
            else XB_SPIN(xb_ld(&bar[XB_TOPGEN]) == tg, bar);
            __builtin_amdgcn_fence(__ATOMIC_ACQUIRE, "agent");
            xb_add(&bar[XB_XGEN(b.x)], 1u);
            asm volatile("s_waitcnt vmcnt(0)" ::: "memory");
        } else {
            XB_SPIN(xb_ld(&bar[XB_XGEN(b.x)]) == gen, bar);
            __builtin_amdgcn_fence(__ATOMIC_ACQUIRE, "agent");
            asm volatile("s_waitcnt vmcnt(0)" ::: "memory");
        }
    }
    __syncthreads();
}


constexpr int NWAVES = 8;
constexpr int DM = 4096;
constexpr int LP = 2048, LS = 4096;
constexpr int MP = 8 * LP, MS = 2 * LS, M = MP + MS;
constexpr int NIN = 16384;
constexpr int NG = 128, PS = 64, TCH = 16, NCH = M / TCH;
constexpr int ESTR = NCH + 9;
constexpr int FGC = 512;
constexpr float RMS_EPS = 1e-6f;
constexpr int TLD = 2048;
constexpr int NP_ = LP / 2, NS_ = LS / 2;
constexpr int VLD = M;

constexpr size_t MiB = 1u << 20;
constexpr size_t WS_CTL = 0, CTL_ZERO_BYTES = 1 * MiB;
constexpr size_t WS_LT = 1 * MiB;
constexpr size_t WS_WGLU = 2 * MiB, WS_WUP = 18 * MiB, WS_WOUT = 50 * MiB, WS_WFA = 82 * MiB;
constexpr size_t WS_T2E = 86 * MiB, WS_T2O = 90 * MiB, WS_T4E = 94 * MiB, WS_T4O = 102 * MiB;
constexpr size_t WS_ME = 110 * MiB, WS_MTF = 126 * MiB;
constexpr size_t WS_A = 158 * MiB;
constexpr size_t WS_H = WS_A, WS_WIN = WS_A + 192 * MiB;
constexpr size_t WS_E = WS_A, WS_F = WS_A + 97 * MiB;
constexpr size_t WS_YG = WS_A + 97 * MiB, WS_YS = WS_A + 193 * MiB;
constexpr size_t WS_OUTB = WS_A;
constexpr size_t WS_U = 478 * MiB, WS_ZS = 574 * MiB;
constexpr size_t WS_MG = WS_U;
constexpr size_t WS_UF = 670 * MiB, WS_YF = WS_UF;
constexpr size_t WS_ZF = 766 * MiB;
constexpr size_t WS_V = 862 * MiB;
constexpr size_t WS_END = 958 * MiB;
constexpr size_t WS_SPEC = WS_LT + 256 * 1024, WS_XH = WS_LT + 512 * 1024;
constexpr int CW_TMO = 0;
constexpr int CW_BAR = 4096;

constexpr int RING_OFF = 0, RING_BYTES = 131072;
constexpr int MISC_OFF = RING_BYTES;
constexpr int XTRA_OFF = MISC_OFF + 512;
constexpr int LDS_BYTES = 147456;

struct Args { const float* in[18]; float* out; unsigned char* ws; int ph_lo, ph_hi; };

__device__ __forceinline__ float wave_sum(float v) {
#pragma unroll
    for (int o = 1; o < 64; o <<= 1) v += __shfl_xor(v, o);
    return v;
}
#define LDS_WAIT() asm volatile("s_waitcnt lgkmcnt(0)" ::: "memory")
__device__ __forceinline__ unsigned pk2(float lo, float hi) { return gp::cvt_pk_bf16(lo, hi); }
__device__ __forceinline__ f32x2 cmul(f32x2 a, f32x2 b) { return (f32x2){a.x * b.x - a.y * b.y, a.x * b.y + a.y * b.x}; }

__device__ __forceinline__ void p0_transpose_item(const float* W, int N, bf16_t* WT, size_t ldo, int kcol0, int k0, int n0, int orow0, LAS float* scr, int lane, float sc = 1.0f) {
    float wv[32];
#pragma unroll
    for (int i = 0; i < 32; ++i) wv[i] = W[(size_t)(k0 + 2 * i + (lane >> 5)) * N + n0 + (lane & 31)];
#pragma unroll
    for (int i = 0; i < 32; ++i) scr[(2 * i + (lane >> 5)) * 33 + (lane & 31)] = wv[i];
    LDS_WAIT(); asm volatile("" ::: "memory");
    const int c = lane & 7;
#pragma unroll
    for (int j = 0; j < 4; ++j) { const int n = (lane >> 3) + 8 * j; const LAS float* s = scr + (8 * c) * 33 + n;
        u32x4 o; o.x = pk2(s[0 * 33] * sc, s[1 * 33] * sc); o.y = pk2(s[2 * 33] * sc, s[3 * 33] * sc); o.z = pk2(s[4 * 33] * sc, s[5 * 33] * sc); o.w = pk2(s[6 * 33] * sc, s[7 * 33] * sc);
        *(u32x4*)(WT + (size_t)(orow0 + n) * ldo + kcol0 + k0 + 8 * c) = o; }
    LDS_WAIT(); asm volatile("" ::: "memory");
}
__device__ __forceinline__ void rms_row_to_bf16(const float* xrow, const float* gain, bf16_t* orow, int lane) {
    const f32x4* xr = (const f32x4*)xrow + lane;
    f32x4 v[16]; float s = 0.f;
#pragma unroll
    for (int j = 0; j < 16; ++j) { v[j] = xr[64 * j]; s += (v[j].x * v[j].x + v[j].y * v[j].y) + (v[j].z * v[j].z + v[j].w * v[j].w); }
    const float r = 1.0f / sqrtf(wave_sum(s) * (1.f / DM) + RMS_EPS);
    const f32x4* g4 = (const f32x4*)gain + lane;
    u32x2* o8 = (u32x2*)orow + lane;
#pragma unroll
    for (int j = 0; j < 16; ++j) { const f32x4 g = g4[64 * j]; u32x2 w; w.x = pk2(v[j].x * r * g.x, v[j].y * r * g.y); w.y = pk2(v[j].z * r * g.z, v[j].w * r * g.w); o8[64 * j] = w; }
}
__device__ __forceinline__ void p0_ssm_group(const Args& a, int g, LAS unsigned char* lds, int tid) {
    LAS f32x2* pw = (LAS f32x2*)lds;
    LAS f32x2* bb = (LAS f32x2*)(lds + 17408);
    LAS f32x2* cm = (LAS f32x2*)(lds + 33792);
    LAS float* Kt = (LAS float*)(lds + 50176);
    const float* lam_re = a.in[5]; const float* lam_im = a.in[6]; const float* log_dt = a.in[7];
    const float* b_re = a.in[8]; const float* b_im = a.in[9]; const float* c_re = a.in[10]; const float* c_im = a.in[11]; const float* dsk = a.in[12];
    bf16_t* ME = (bf16_t*)(a.ws + WS_ME) + (size_t)g * 256 * 256; bf16_t* MTF = (bf16_t*)(a.ws + WS_MTF) + (size_t)g * 256 * 512; f32x2* LT = (f32x2*)(a.ws + WS_LT);
    LAS f32x2* qd = (LAS f32x2*)(lds + 82944);
    { const int d = (tid >> 6) & 1, p = tid & 63, eq = tid >> 7;
        const float lre = fminf(lam_re[(d * NG + g) * PS + p], -1e-4f), lim = lam_im[(d * NG + g) * PS + p], dt = expf(log_dt[d * NG + g]);
#pragma unroll
        for (int k = 1; k <= 4; ++k) { const int e = eq * 4 + k; const float mag = expf(lre * dt * (float)e); float s, c; sincosf(lim * dt * (float)e, &s, &c); pw[(d * 17 + e) * 64 + p] = (f32x2){mag * c, mag * s};
            if (e == 16) LT[(g * 2 + d) * 64 + p] = (f32x2){mag * c, mag * s}; }
        if (eq == 0) { pw[(d * 17) * 64 + p] = (f32x2){1.f, 0.f};
            const float ar = lre * dt, ai = lim * dt; float sh = sinf(0.5f * ai), s, co; sincosf(ai, &s, &co);
            const float nr = expm1f(ar) * co - 2.f * sh * sh, ni = expf(ar) * s, den = lre * lre + lim * lim;
            qd[d * 64 + p] = (f32x2){(nr * lre + ni * lim) / den, (ni * lre - nr * lim) / den}; }
    }
#pragma unroll
    for (int j = 0; j < 4; ++j) { const int idx = tid + 512 * j;
        const int d = idx >> 10, c = (idx >> 6) & 15, p = idx & 63; const size_t ci = ((size_t)(d * NG + g) * 16 + c) * PS + p;
        cm[(d * 16 + c) * 64 + p] = (f32x2){c_re[ci], c_im[ci]}; }
    __syncthreads();
#pragma unroll
    for (int j = 0; j < 4; ++j) { const int idx = tid + 512 * j;
        const int d = idx >> 10, p = (idx >> 4) & 63, c = idx & 15;
        const size_t bi = ((size_t)(d * NG + g) * PS + p) * 16 + c;
        bb[(d * 64 + p) * 16 + c] = cmul(qd[d * 64 + p], (f32x2){b_re[bi], b_im[bi]}); }
    __syncthreads();
    { const int d = tid >> 8, e = (tid >> 4) & 15, c = tid & 15; float acc[16];
#pragma unroll
      for (int q = 0; q < 16; ++q) acc[q] = 0.f;
      for (int p = 0; p < 64; ++p) { const f32x2 Gm = cmul(cm[(d * 16 + c) * 64 + p], pw[(d * 17 + e) * 64 + p]);
#pragma unroll
          for (int q = 0; q < 16; ++q) { const f32x2 b = bb[(d * 64 + p) * 16 + q]; acc[q] += Gm.x * b.x - Gm.y * b.y; } }
#pragma unroll
      for (int q = 0; q < 16; ++q) Kt[((d * 16 + e) * 16 + c) * 16 + q] = acc[q];
    }
    __syncthreads();
    const float dsk_c = dsk[16 * g + ((tid >> 5) & 15)];
    for (int j = 0; j < 16; ++j) { const int q = tid + 512 * j, row = q >> 5, o = q & 31, col0 = o * 8;
        {
            const int i = row >> 4, c = row & 15, jj = col0 >> 4, cq0 = col0 & 15; float v[8];
#pragma unroll
            for (int k = 0; k < 8; ++k) { const int cq = cq0 + k; float x = 0.f;
                if (jj <= i) x += Kt[((0 * 16 + (i - jj)) * 16 + c) * 16 + cq];
                if (jj >= i) x += Kt[((1 * 16 + (jj - i)) * 16 + c) * 16 + cq];
                if (jj == i && cq == c) x += dsk_c;
                v[k] = x; }
            u32x4 w; w.x = pk2(v[0], v[1]); w.y = pk2(v[2], v[3]); w.z = pk2(v[4], v[5]); w.w = pk2(v[6], v[7]);
            *(u32x4*)(MTF + (size_t)row * 512 + col0) = w; }
        {
            const int i = row >> 4, c = row & 15, d = col0 >> 7, p0 = (col0 & 127) >> 1, e = d == 0 ? i + 1 : 16 - i; unsigned w[4];
#pragma unroll
            for (int k = 0; k < 4; ++k) { const f32x2 Gm = cmul(cm[(d * 16 + c) * 64 + p0 + k], pw[(d * 17 + e) * 64 + p0 + k]); w[k] = pk2(Gm.x, -Gm.y); }
            *(u32x4*)(MTF + (size_t)row * 512 + 256 + col0) = (u32x4){w[0], w[1], w[2], w[3]}; }
        {
            const int d = row >> 7, p = (row & 127) >> 1, im = row & 1, jj = col0 >> 4, cq0 = col0 & 15, e = d == 0 ? 15 - jj : jj; float v[8];
            const f32x2 pe = pw[(d * 17 + e) * 64 + p];
#pragma unroll
            for (int k = 0; k < 8; ++k) { const f32x2 Q = cmul(pe, bb[(d * 64 + p) * 16 + cq0 + k]); v[k] = im ? Q.y : Q.x; }
            u32x4 w; w.x = pk2(v[0], v[1]); w.y = pk2(v[2], v[3]); w.z = pk2(v[4], v[5]); w.w = pk2(v[6], v[7]);
            *(u32x4*)(ME + (size_t)row * 256 + col0) = w; }
    }
    __syncthreads();
}
__device__ __forceinline__ void p0_wfa_task(const float* Wf, bf16_t* WFA, const LAS f32x2* trig, int task, int lane) {
    const int g = task >> 9, c = ((task >> 6) & 7) * 64 + lane, d0 = (task & 63) * 8;
    float ac[8], as[8];
#pragma unroll
    for (int j = 0; j < 8; ++j) { ac[j] = 0.f; as[j] = 0.f; }
    const float* wp = Wf + (size_t)g * FGC * FGC + d0; int idx = 0;
#pragma unroll 4
    for (int cp = 0; cp < FGC; ++cp) { const f32x2 t = trig[idx]; idx = (idx + c) & 511;
        const f32x4 w0 = *(const f32x4*)(wp + (size_t)cp * FGC), w1 = *(const f32x4*)(wp + (size_t)cp * FGC + 4);
#pragma unroll
        for (int j = 0; j < 4; ++j) { ac[j] += t.x * w0[j]; as[j] += t.y * w0[j]; ac[4 + j] += t.x * w1[j]; as[4 + j] += t.y * w1[j]; } }
    const float sc = 0.04419417382f;
#pragma unroll
    for (int j = 0; j < 8; ++j) { WFA[((size_t)(g * 1024 + d0 + j)) * FGC + c] = (bf16_t)(pk2(ac[j] * sc, 0.f) & 0xffffu); WFA[((size_t)(g * 1024 + 512 + d0 + j)) * FGC + c] = (bf16_t)(pk2(as[j] * sc, 0.f) & 0xffffu); }
}
template <int ODD> __device__ __forceinline__ u32x4 dft_piece(int k, int j0, int N, float rs) {
    float v[8]; const int H = N >> 1, Lm = ODD ? 2 * N : N, mul = ODD ? 2 * k + 1 : k; const float inv = 1.0f / (float)Lm;
#pragma unroll
    for (int jj = 0; jj < 8; ++jj) { const int j = j0 + jj, n = j < H ? j : j - H; const float fr = (float)((mul * n) & (Lm - 1)) * inv;
        v[jj] = j < H ? __builtin_amdgcn_cosf(fr) * rs : (j == H ? (ODD ? ((k & 1) ? rs : -rs) : 0.f) : -__builtin_amdgcn_sinf(fr) * rs); }
    u32x4 w; w.x = pk2(v[0], v[1]); w.y = pk2(v[2], v[3]); w.z = pk2(v[4], v[5]); w.w = pk2(v[6], v[7]); return w;
}

constexpr int I_IN = (DM / 64) * (NIN / 32), I_GLU = (2048 / 64) * (4096 / 32), I_UP = (2048 / 64) * (4096 / 32), I_OUT = (DM / 64) * (DM / 32);
constexpr int P0_NITEMS = I_IN + I_GLU + 2 * I_UP + I_OUT;
#ifndef P0_NXK
#define P0_NXK 3
#endif
__device__ __forceinline__ void p0_transpose_dispatch(const Args& a, int r, LAS float* scr, int lane) {
        if (r < I_IN) { const int nb = r % (NIN / 32), kb = r / (NIN / 32), n0 = 32 * nb; int orow0 = n0;
            float sc = 1.0f;
            if (n0 >= 8192) { const int c = n0 - 8192, hh = c >> 12, rem = c & 4095; orow0 = 8192 + (rem >> 7) * 256 + hh * 128 + (rem & 127); sc = -1.44269504089f; }
            p0_transpose_item(a.in[4], NIN, (bf16_t*)(a.ws + WS_WIN), DM, 0, 64 * kb, n0, orow0, scr, lane, sc); return; } r -= I_IN;
        if (r < I_GLU) { const int nb = r % 128, kb = r / 128, n0 = 32 * nb, hh = n0 >> 11, rem = n0 & 2047, orow0 = (rem >> 7) * 256 + hh * 128 + (rem & 127);
            p0_transpose_item(a.in[13], 4096, (bf16_t*)(a.ws + WS_WGLU), 2048, 0, 64 * kb, n0, orow0, scr, lane); return; } r -= I_GLU;
        if (r < I_UP) { const int nb = r % 128, kb = r / 128; p0_transpose_item(a.in[15], 4096, (bf16_t*)(a.ws + WS_WUP), 4096, 0, 64 * kb, 32 * nb, 32 * nb, scr, lane); return; } r -= I_UP;
        if (r < I_UP) { const int nb = r % 128, kb = r / 128; p0_transpose_item(a.in[16], 4096, (bf16_t*)(a.ws + WS_WUP), 4096, 2048, 64 * kb, 32 * nb, 32 * nb, scr, lane); return; } r -= I_UP;
        { const int nb = r % 128, kb = r / 128; p0_transpose_item(a.in[17], 4096, (bf16_t*)(a.ws + WS_WOUT), 4096, 0, 64 * kb, 32 * nb, 32 * nb, scr, lane); }
}
__device__ __forceinline__ void p0_compute_part(const Args& a, const LAS f32x2* trig, int tid, int lane, int vcu, int gw, int NGW, int G) {
    for (int task = gw; task < 2048; task += NGW) p0_wfa_task(a.in[14], (bf16_t*)(a.ws + WS_WFA), trig, task, lane);
    const int gt = vcu * (NWAVES * 64) + tid, NT = G * NWAVES * 64;
    bf16_t* T2E = (bf16_t*)(a.ws + WS_T2E); bf16_t* T2O = (bf16_t*)(a.ws + WS_T2O); bf16_t* T4E = (bf16_t*)(a.ws + WS_T4E); bf16_t* T4O = (bf16_t*)(a.ws + WS_T4O);
    for (int q = gt; q < NP_ * (NP_ / 8); q += NT) { const int k = q >> 7, j0 = (q & 127) * 8; *(u32x4*)(T2E + (size_t)k * TLD + j0) = dft_piece<0>(k, j0, NP_, 0.02209708691f); *(u32x4*)(T2O + (size_t)k * TLD + j0) = dft_piece<1>(k, j0, NP_, 0.02209708691f); }
    for (int q = gt; q < NS_ * (NS_ / 8); q += NT) { const int k = q >> 8, j0 = (q & 255) * 8; *(u32x4*)(T4E + (size_t)k * TLD + j0) = dft_piece<0>(k, j0, NS_, 0.015625f); *(u32x4*)(T4O + (size_t)k * TLD + j0) = dft_piece<1>(k, j0, NS_, 0.015625f); }
}
__device__ __forceinline__ void p0_prologue(const Args& a, LAS unsigned char* lds, int tid, int lane, int wave, int vcu, int G) {
    const bool sym = (G == 2 * NG); const bool ssm_wg = sym ? ((vcu & 1) == 0) : (vcu < NG);
    if (sym) { if (ssm_wg) p0_ssm_group(a, vcu >> 1, lds, tid); }
    else for (int g = vcu; g < NG; g += G) p0_ssm_group(a, g, lds, tid);
    LAS f32x2* trig = (LAS f32x2*)(lds + XTRA_OFF);
    { const float fr = (float)tid * (1.0f / 512.0f); trig[tid] = (f32x2){__builtin_amdgcn_cosf(fr), __builtin_amdgcn_sinf(fr)}; }
    __syncthreads();
    const int gw = vcu * NWAVES + wave, NGW = G * NWAVES;
    int step = 0; const int cslot = wave * 5;
#define P0_STEP() do { if (step == cslot) p0_compute_part(a, trig, tid, lane, vcu, gw, NGW, G); ++step; } while (0)
    LAS float* scr = (LAS float*)(lds + RING_OFF + wave * 16384);
    const int NX = (G > NG) ? (G - NG) * NWAVES * P0_NXK : 0;
    if (!ssm_wg) { const int oi = sym ? (vcu >> 1) : (vcu - NG);
        for (int it = oi * NWAVES + wave; it < NX; it += (G - NG) * NWAVES) { P0_STEP(); p0_transpose_dispatch(a, it, scr, lane); } }
    for (int it = NX + gw; it < P0_NITEMS; it += NGW) { P0_STEP(); p0_transpose_dispatch(a, it, scr, lane); }
    for (int m = gw; m < M; m += NGW) { P0_STEP(); const float* xr = m < MP ? a.in[0] + (size_t)m * DM : a.in[1] + (size_t)(m - MP) * DM;
        rms_row_to_bf16(xr, a.in[2], (bf16_t*)(a.ws + WS_H) + (size_t)m * DM, lane); }
    if (step <= cslot) p0_compute_part(a, trig, tid, lane, vcu, gw, NGW, G);
#undef P0_STEP
}

__device__ __forceinline__ int xcd_remap(int L, int nwg) { const int q = nwg / 8, r = nwg % 8, x = L % 8, off = L / 8; return (x < r ? x * (q + 1) : r * (q + 1) + (x - r) * q) + off; }
template <int NSEG> struct TileSched {
    int nM, nN, nwg, G, c; const char* A0; const char* B0; const char* A1; const char* B1; size_t a_tile, b_tile; int nt0, nt1, flags0; int wgm = 8;
    __device__ __forceinline__ bool next(int i, gp::SU& u) const {
        const int ui = NSEG == 2 ? (i >> 1) : i, seg = NSEG == 2 ? (i & 1) : 0;
        const long L = (long)ui * G + c; if (L >= nwg) return false;
        const int wgid = xcd_remap((int)L, nwg);
        const int nig = wgm * nN, gid = wgid / nig, fm = gid * wgm, gsz = (nM - fm) < wgm ? (nM - fm) : wgm;
        u.pm = fm + ((wgid % nig) % gsz); u.pn = (wgid % nig) / gsz;
        u.A = (seg ? A1 : A0) + (size_t)u.pm * a_tile; u.B = (seg ? B1 : B0) + (size_t)u.pn * b_tile; u.nt = seg ? nt1 : nt0;
        u.flags = NSEG == 1 ? (gp::F_EPI | gp::F_ZERO) : (seg ? (gp::F_EPI | gp::F_ZERO | gp::F_SEG1) : flags0);
        return true; }
};
template <int NSEG> struct SsmSched {
    int G, c; const char* U; const char* E; const char* Bm; size_t b_group; int ksegB;
    __device__ __forceinline__ bool next(int i, gp::SU& u) const {
        const int ui = NSEG == 2 ? (i >> 1) : i, seg = NSEG == 2 ? (i & 1) : 0;
        const long L = (long)ui * G + c; if (L >= NG * 6) return false;
        const int wgid = xcd_remap((int)L, NG * 6), g = wgid / 6, ct = wgid % 6;
        u.pm = ct; u.pn = g; u.nt = 4;
        u.A = seg ? E + ((size_t)g * ESTR + (size_t)ct * 256) * 512 : U + ((size_t)g * NCH + (size_t)ct * 256) * 512; u.B = Bm + (size_t)g * b_group + (seg ? ksegB : 0);
        u.flags = NSEG == 1 ? (gp::F_EPI | gp::F_ZERO) : (seg ? (gp::F_EPI | gp::F_ZERO | gp::F_SEG1) : 0);
        return true; }
};
struct FaSched {
    int G, c; const char* A; const char* F;
    __device__ __forceinline__ bool next(int i, gp::SU& u) const {
        const long L = (long)i * G + c; if (L >= 8 * 96) return false;
        const int wgid = xcd_remap((int)L, 8 * 96), ct = wgid >> 3, rt = wgid & 7, g = rt >> 1, tk0 = ct * 256;
        int o, Hh; if (tk0 < MP) { o = tk0 & (LP - 1); Hh = LP / 4; } else { o = (tk0 - MP) & (LS - 1); Hh = LS / 4; }
        const int ab = (o / Hh) & 1;
        u.pm = rt; u.pn = ct; u.nt = 8;
        u.A = A + (size_t)(g * 1024 + ab * 512 + (rt & 1) * 256) * FGC * 2; u.B = F + (size_t)tk0 * 2048 * 2 + (size_t)g * FGC * 2;
        u.flags = gp::F_EPI | gp::F_ZERO; return true; }
};
struct FbSched {
    int G, c; const char* T2E; const char* T2O; const char* T4E; const char* T4O; const char* V;
    __device__ __forceinline__ bool next(int i, gp::SU& u) const {
        const long L = (long)i * G + c; if (L >= 768) return false;
        int rt, pn, tok0, N;
        if (L < 256) { const int x = (int)L & 7, j = (int)L >> 3; rt = (x & 3) * 4 + (j & 3); pn = j >> 2; tok0 = MP + (x >> 2) * LS; N = NS_; u.A = ((rt & 1) ? T4O : T4E) + (size_t)(rt >> 1) * 256 * TLD * 2; }
        else { const int q = (int)L - 256, ii = q >> 8, cc = q & 255, x = cc & 7, j = cc >> 3; rt = 4 * ii + (j & 3); pn = j >> 2; tok0 = x * LP; N = NP_; u.A = ((rt & 1) ? T2O : T2E) + (size_t)(rt >> 1) * 256 * TLD * 2; }
        const int par = rt & 1, kt = rt >> 1;
        u.nt = N / 64; u.B = V + ((size_t)pn * 256 * VLD + (size_t)tok0 + (size_t)par * N) * 2; u.pm = tok0 + 512 * kt + par; u.pn = pn;
        u.flags = gp::F_EPI | gp::F_ZERO; return true; }
};

typedef f32x4 AccT[2][2][4][2];
struct EpiG1 { bf16_t *U, *ZS, *UF, *ZF, *GT;
    __device__ __forceinline__ void operator()(AccT& acc, const gp::SU& u, int wr, int wc, int fr, int fq) const {
        const int pn = u.pn; const size_t row0 = (size_t)u.pm * 256;
        if (pn < 8) {
            bf16_t* base = U + ((size_t)(16 * pn) * M + row0) * 16;
            const unsigned lo = gp::opaque_u((unsigned)((2 * wc + (fq >> 1)) * M + wr * 64 + fr) * 16u + 8u * (unsigned)(fq & 1));
#pragma unroll
            for (int ai = 0; ai < 2; ++ai)
#pragma unroll
                for (int m = 0; m < 4; ++m)
#pragma unroll
                    for (int bj = 0; bj < 2; ++bj) *(u32x4*)(base + ((size_t)(8 * bj) * M + ai * 128 + m * 16) * 16 + lo) = gp::pack8(acc[ai][bj][m][0], acc[ai][bj][m][1]);
        } else if (pn < 16) {
            bf16_t* zb = ZS + ((size_t)u.pm * 8 + (pn - 8)) * 65536;
            const unsigned lo = gp::opaque_u((unsigned)((wr * 4 + wc) * 8192 + (fq * 16 + fr) * 8));
#pragma unroll
            for (int ai = 0; ai < 2; ++ai)
#pragma unroll
                for (int m = 0; m < 4; ++m)
#pragma unroll
                    for (int bj = 0; bj < 2; ++bj) *(u32x4*)(zb + (size_t)((ai * 4 + m) * 2 + bj) * 512 + lo) = gp::pack8(gp::act4<1>(acc[ai][bj][m][0]), gp::act4<1>(acc[ai][bj][m][1]));
        }
        else if (pn < 24) gp::store_tile<0>(acc, UF + row0 * 2048 + (pn - 16) * 256, 2048, wr, wc, fr, fq);
        else if (pn < 32) gp::store_tile<1>(acc, ZF + row0 * 2048 + (pn - 24) * 256, 2048, wr, wc, fr, fq);
        else {
            bf16_t* rb = GT + ((size_t)u.pm * 32 + (pn - 32)) * 32768; bf16_t* sb = rb + (size_t)M * 4096;
            const unsigned lo = gp::opaque_u((unsigned)((wr * 4 + wc) * 4096 + (fq * 16 + fr) * 8));
#pragma unroll
            for (int ai = 0; ai < 2; ++ai)
#pragma unroll
                for (int m = 0; m < 4; ++m) { const size_t off = (size_t)(ai * 4 + m) * 512; f32x4 rr[2], ss[2];
#pragma unroll
                    for (int n = 0; n < 2; ++n)
#pragma unroll
                        for (int k = 0; k < 4; ++k) { const float e0 = 1.0f + fminf(__builtin_amdgcn_exp2f(acc[ai][0][m][n][k]), 1e15f), e1 = 1.0f + fminf(__builtin_amdgcn_exp2f(acc[ai][1][m][n][k]), 1e15f);
                            const float ip = __builtin_amdgcn_rcpf(e0 * e1); ss[n][k] = e0 * ip; rr[n][k] = e1 * e1 * ip; }
                    *(u32x4*)(rb + off + lo) = gp::pack8(rr[0], rr[1]); *(u32x4*)(sb + off + lo) = gp::pack8(ss[0], ss[1]); }
        }
    }
};
struct EpiSS1 { bf16_t* E;
    __device__ __forceinline__ void operator()(AccT& acc, const gp::SU& u, int wr, int wc, int fr, int fq) const {
        gp::store_tile<0>(acc, E + ((size_t)u.pn * ESTR + (size_t)u.pm * 256) * 256, 256, wr, wc, fr, fq); }
};
struct EpiSS3 { bf16_t* YG;
    __device__ __forceinline__ void operator()(AccT& acc, const gp::SU& u, int wr, int wc, int fr, int fq) const {
        gp::store_tile<3>(acc, YG + ((size_t)u.pn * NCH + (size_t)u.pm * 256) * 256, 256, wr, wc, fr, fq); }
};
struct EpiFA { bf16_t* V;
    __device__ __forceinline__ void operator()(AccT& acc, const gp::SU& u, int wr, int wc, int fr, int fq) const {
        gp::store_tile<0>(acc, V + (size_t)u.pm * 256 * VLD + (size_t)u.pn * 256, VLD, wr, wc, fr, fq); }
};
struct EpiFB { const bf16_t* ZF; bf16_t* YF; const float* SPEC;
    __device__ __forceinline__ void operator()(AccT& acc, const gp::SU& u, int wr, int wc, int fr, int fq) const {
        const size_t t0 = (size_t)u.pm * 2048 + u.pn * 256; const bf16_t* zb = ZF + t0; bf16_t* yb = YF + t0;
        const unsigned lo = gp::opaque_u((unsigned)(wr * 64 + fr) * 4096u + (unsigned)(wc * 32 + 8 * fq));
        u32x4 z[2][4][2];
#pragma unroll
        for (int ai = 0; ai < 2; ++ai)
#pragma unroll
            for (int m = 0; m < 4; ++m)
#pragma unroll
                for (int bj = 0; bj < 2; ++bj) z[ai][m][bj] = *(const u32x4*)(zb + (size_t)(ai * 128 + m * 16) * 4096 + bj * 128 + lo);
        __builtin_amdgcn_sched_barrier(0);
        if ((u.pm & 1) == 0) { const int b = u.pm < MP ? (u.pm >> 11) : 8 + ((u.pm - MP) >> 12); const float sg = (fr & 1) ? -1.f : 1.f;
            const float* sp = SPEC + (size_t)b * 2048 + u.pn * 256 + gp::opaque_u((unsigned)(wc * 32 + 8 * fq));
#pragma unroll
            for (int bj = 0; bj < 2; ++bj) { const f32x4 s0 = *(const f32x4*)(sp + bj * 128) * sg, s1 = *(const f32x4*)(sp + bj * 128 + 4) * sg;
#pragma unroll
                for (int ai = 0; ai < 2; ++ai)
#pragma unroll
                    for (int m = 0; m < 4; ++m) { acc[ai][bj][m][0] += s0; acc[ai][bj][m][1] += s1; } } }
#pragma unroll
        for (int ai = 0; ai < 2; ++ai)
#pragma unroll
            for (int m = 0; m < 4; ++m) { const size_t off = (size_t)(ai * 128 + m * 16) * 4096;
#pragma unroll
                for (int bj = 0; bj < 2; ++bj) { f32x4 z0, z1; gp::unpack8(z[ai][m][bj], z0, z1);
                    *(u32x4*)(yb + off + bj * 128 + lo) = gp::pack8(acc[ai][bj][m][0] * z0, acc[ai][bj][m][1] * z1); } }
    }
};
struct EpiG2 { const bf16_t* ZS; bf16_t* YS;
    __device__ __forceinline__ void operator()(AccT& acc, const gp::SU& u, int wr, int wc, int fr, int fq) const {
        const size_t t0 = (size_t)u.pm * 256 * 2048 + u.pn * 128; bf16_t* yb = YS + t0;
        const bf16_t* zb = ZS + ((size_t)u.pm * 8 + (u.pn >> 1)) * 65536 + (size_t)(u.pn & 1) * 512;
        const unsigned lo = gp::opaque_u((unsigned)(wr * 64 + fr) * 2048u + (unsigned)(wc * 32 + 8 * fq));
        const unsigned lz = gp::opaque_u((unsigned)((wr * 4 + wc) * 8192 + (fq * 16 + fr) * 8));
        u32x4 z[2][4];
#pragma unroll
        for (int ai = 0; ai < 2; ++ai)
#pragma unroll
            for (int m = 0; m < 4; ++m) z[ai][m] = *(const u32x4*)(zb + (size_t)(ai * 4 + m) * 1024 + lz);
        __builtin_amdgcn_sched_barrier(0);
#pragma unroll
        for (int ai = 0; ai < 2; ++ai)
#pragma unroll
            for (int m = 0; m < 4; ++m) { const size_t off = (size_t)(ai * 128 + m * 16) * 2048;
                f32x4 z0, z1; gp::unpack8(z[ai][m], z0, z1);
                const f32x4 o0 = acc[ai][0][m][0] * gp::act4<2>(acc[ai][1][m][0]) * z0, o1 = acc[ai][0][m][1] * gp::act4<2>(acc[ai][1][m][1]) * z1;
                *(u32x4*)(yb + off + lo) = gp::pack8(o0, o1); }
    }
};
struct EpiG3 { const bf16_t* GT; bf16_t* MG;
    __device__ __forceinline__ void operator()(AccT& acc, const gp::SU& u, int wr, int wc, int fr, int fq) const {
        const bool fin = (u.flags & gp::F_SEG1) != 0; const size_t t0 = (size_t)u.pm * 256 * 4096 + u.pn * 256;
        const bf16_t* gb = GT + ((size_t)u.pm * 32 + 2 * u.pn) * 32768 + (fin ? (size_t)M * 4096 : (size_t)0); bf16_t* mb = MG + t0;
        const unsigned lo = gp::opaque_u((unsigned)(wr * 64 + fr) * 4096u + (unsigned)(wc * 32 + 8 * fq));
        const unsigned lg = gp::opaque_u((unsigned)((wr * 4 + wc) * 4096 + (fq * 16 + fr) * 8));
        u32x4 gw[2][4][2];
#pragma unroll
        for (int ai = 0; ai < 2; ++ai)
#pragma unroll
            for (int m = 0; m < 4; ++m)
#pragma unroll
                for (int bj = 0; bj < 2; ++bj) gw[ai][m][bj] = *(const u32x4*)(gb + (size_t)bj * 32768 + (size_t)(ai * 4 + m) * 512 + lg);
        __builtin_amdgcn_sched_barrier(0);
#pragma unroll
        for (int ai = 0; ai < 2; ++ai)
#pragma unroll
            for (int m = 0; m < 4; ++m)
#pragma unroll
                for (int bj = 0; bj < 2; ++bj) { f32x4 g0, g1; gp::unpack8(gw[ai][m][bj], g0, g1);
                    if (!fin) { acc[ai][bj][m][0] *= g0; acc[ai][bj][m][1] *= g1; }
                    else *(u32x4*)(mb + (size_t)(ai * 128 + m * 16) * 4096 + bj * 128 + lo) = gp::pack8(acc[ai][bj][m][0] * g0, acc[ai][bj][m][1] * g1); }
    }
};
struct EpiG4 { bf16_t* O;
    __device__ __forceinline__ void operator()(AccT& acc, const gp::SU& u, int wr, int wc, int fr, int fq) const {
        gp::store_tile<0>(acc, O + (size_t)u.pm * 256 * 4096 + u.pn * 256, 4096, wr, wc, fr, fq); }
};

template <int SGN> __device__ __forceinline__ void ss2_scan_dir(unsigned* E32, const f32x2* LT, int g, int chunk0, int nc, int lane) {
    constexpr int D = 64; constexpr int dir = SGN > 0 ? 0 : 1;
    unsigned* p = E32 + ((size_t)g * ESTR + chunk0 + (dir ? nc - 1 : 0)) * 128 + dir * 64;
    const f32x2 lt = LT[(g * 2 + dir) * 64 + lane];
    float sr = 0.f, si = 0.f;
    for (int kk = 0; kk < nc; kk += D) {
        unsigned v[D];
#pragma unroll
        for (int j = 0; j < D; ++j) v[j] = p[SGN * j * 128 + lane];
        __builtin_amdgcn_sched_barrier(0);
#pragma unroll
        for (int j = 0; j < D; ++j) {
            p[SGN * j * 128 + lane] = pk2(sr, si);
            const float er = gp::bf_lo(v[j]), ei = gp::bf_hi(v[j]);
            const float nr = lt.x * sr - lt.y * si + er, ni = lt.x * si + lt.y * sr + ei; sr = nr; si = ni; }
        p += SGN * D * 128;
    }
}
__device__ __forceinline__ void ss2_scan(unsigned* E32, const f32x2* LT, int g, int dir, int chunk0, int nc, int lane) {
    if (dir == 0) ss2_scan_dir<1>(E32, LT, g, chunk0, nc, lane); else ss2_scan_dir<-1>(E32, LT, g, chunk0, nc, lane);
}
__device__ __forceinline__ void fold_task(const bf16_t* UF, bf16_t* F, bf16_t* XH, int t, int lane) {
    int b, n, L, tok0; if (t < 8 * (LP / 4)) { b = t >> 9; n = t & 511; L = LP; tok0 = b * LP; } else { const int q = t - 8 * (LP / 4); b = 8 + (q >> 10); n = q & 1023; L = LS; tok0 = MP + (q >> 10) * LS; }
    const int N = L >> 1, H = L >> 2;
    const int i0 = n, i1 = n + N, i2 = n ? N - n : H, i3 = n ? 2 * N - n : H + N;
    const u32x4* r0 = (const u32x4*)(UF + (size_t)(tok0 + i0) * 2048) + lane; const u32x4* r1 = (const u32x4*)(UF + (size_t)(tok0 + i1) * 2048) + lane;
    const u32x4* r2 = (const u32x4*)(UF + (size_t)(tok0 + i2) * 2048) + lane; const u32x4* r3 = (const u32x4*)(UF + (size_t)(tok0 + i3) * 2048) + lane;
    u32x4* o0 = (u32x4*)(F + (size_t)(tok0 + n) * 2048) + lane; u32x4* o1 = (u32x4*)(F + (size_t)(tok0 + H + n) * 2048) + lane;
    u32x4* o2 = (u32x4*)(F + (size_t)(tok0 + N + n) * 2048) + lane; u32x4* o3 = (u32x4*)(F + (size_t)(tok0 + N + H + n) * 2048) + lane;
    u32x4* ox = (u32x4*)(XH + (size_t)b * 2048) + lane;
#pragma unroll
    for (int i = 0; i < 4; ++i) { f32x4 a0, a1, b0, b1, c0, c1, d0, d1;
        gp::unpack8(r0[64 * i], a0, a1); gp::unpack8(r1[64 * i], b0, b1); gp::unpack8(r2[64 * i], c0, c1); gp::unpack8(r3[64 * i], d0, d1);
        const f32x4 p0 = a0 + b0, p1 = a1 + b1, q0 = a0 - b0, q1 = a1 - b1, pm0 = c0 + d0, pm1 = c1 + d1, qm0 = c0 - d0, qm1 = c1 - d1;
        if (n) { o0[64 * i] = gp::pack8(p0 + pm0, p1 + pm1); o1[64 * i] = gp::pack8(p0 - pm0, p1 - pm1); o2[64 * i] = gp::pack8(q0 - qm0, q1 - qm1); o3[64 * i] = gp::pack8(q0 + qm0, q1 + qm1); }
        else { o0[64 * i] = gp::pack8(p0, p1); o1[64 * i] = (u32x4){0u, 0u, 0u, 0u}; o2[64 * i] = gp::pack8(q0, q1); o3[64 * i] = gp::pack8(qm0, qm1); ox[64 * i] = gp::pack8(pm0, pm1); } }
}
__device__ __forceinline__ void spec_wave(const bf16_t* WFA, const bf16_t* XH, float* SPEC, int ch, int lane) {
    const int g = ch >> 9, d = ch & 511;
    f32x4 w0, w1; gp::unpack8(*((const u32x4*)(WFA + (size_t)(g * 1024 + d) * FGC) + lane), w0, w1);
    u32x4 xv[10];
#pragma unroll
    for (int b = 0; b < 10; ++b) xv[b] = *((const u32x4*)(XH + (size_t)b * 2048 + g * FGC) + lane);
    float res = 0.f;
#pragma unroll
    for (int b = 0; b < 10; ++b) { f32x4 x0, x1; gp::unpack8(xv[b], x0, x1);
        float s = (w0[0] * x0[0] + w0[1] * x0[1]) + (w0[2] * x0[2] + w0[3] * x0[3]) + (w1[0] * x1[0] + w1[1] * x1[1]) + (w1[2] * x1[2] + w1[3] * x1[3]);
        s = wave_sum(s) * (b < 8 ? 0.02209708691f : 0.015625f);
        if (lane == b) res = s; }
    if (lane < 10) SPEC[(size_t)lane * 2048 + ch] = res;
}
__device__ __forceinline__ void final_row(const bf16_t* orow, const float* xrow, const float* gain, float* yrow, int lane) {
    const u32x4* o16 = (const u32x4*)orow + lane; u32x4 ov[8]; float s = 0.f;
#pragma unroll
    for (int j = 0; j < 8; ++j) { ov[j] = o16[64 * j]; f32x4 a, b; gp::unpack8(ov[j], a, b); s += (a.x * a.x + a.y * a.y) + (a.z * a.z + a.w * a.w) + (b.x * b.x + b.y * b.y) + (b.z * b.z + b.w * b.w); }
    const float r = 1.0f / sqrtf(wave_sum(s) * (1.f / DM) + RMS_EPS);
#pragma unroll
    for (int j = 0; j < 8; ++j) { f32x4 a, b; gp::unpack8(ov[j], a, b); const size_t e0 = (size_t)(lane + 64 * j) * 8;
        const f32x4 x0 = *(const f32x4*)(xrow + e0), x1 = *(const f32x4*)(xrow + e0 + 4), g0 = *(const f32x4*)(gain + e0), g1 = *(const f32x4*)(gain + e0 + 4);
        *(f32x4*)(yrow + e0) = x0 + a * r * g0; *(f32x4*)(yrow + e0 + 4) = x1 + b * r * g1; }
}

#ifndef MK_N_LAUNCHES
#define MK_N_LAUNCHES 1
#endif
constexpr int N_PHASES = 9;
constexpr bool ONE_LAUNCH = (MK_N_LAUNCHES == 1);
#ifndef PG8_SP2
#define PG8_SP2 true
#endif
#ifndef PG8_ALIGN
#define PG8_ALIGN true
#endif

__global__ void __launch_bounds__(NWAVES * 64, 2) hybrid_fwd(Args args) {
    extern __shared__ __attribute__((aligned(16))) unsigned char lds_raw[];
    LAS unsigned char* lds = (LAS unsigned char*)lds_raw;
    volatile LAS unsigned* MISC = (volatile LAS unsigned*)(lds + MISC_OFF);
    const int tid = threadIdx.x, lane = tid & 63, wave = __builtin_amdgcn_readfirstlane(tid >> 6);
    const int G = gridDim.x; const int bx = blockIdx.x; const int vcu = (G % 8 == 0) ? (bx % 8) * (G / 8) + bx / 8 : bx;
    unsigned char* ws = args.ws;
    unsigned* ctl = (unsigned*)(ws + WS_CTL);
    for (int u = tid; u < 512 / 4; u += NWAVES * 64) ((LAS unsigned*)(lds + MISC_OFF))[u] = 0u;
    __syncthreads();
    XcdBarrier bar; bar.bar = ctl + CW_BAR; bar.x = 0; bar.st = nullptr;
    if (ONE_LAUNCH) bar = xcd_barrier_post(ctl + CW_BAR, MISC + 8);
#define GRID_BAR() do { if (ONE_LAUNCH) xcd_barrier(bar); } while (0)
    const int lo = args.ph_lo, hi = args.ph_hi;
#define IN(k) (lo <= (k) && (k) < hi)
#define BOTH(k) (IN(k) && IN((k) + 1))

    if (IN(0)) { p0_prologue(args, lds, tid, lane, wave, vcu, G); if (BOTH(0)) GRID_BAR(); }

    if (IN(1)) {
        TileSched<1> S; S.nM = M / 256; S.nN = NIN / 256; S.nwg = S.nM * S.nN; S.G = G; S.c = bx;
        S.wgm = 4;
        S.A0 = (const char*)(ws + WS_H); S.B0 = (const char*)(ws + WS_WIN); S.A1 = S.A0; S.B1 = S.B0; S.a_tile = (size_t)256 * DM * 2; S.b_tile = (size_t)256 * DM * 2; S.nt0 = DM / 64; S.nt1 = 0; S.flags0 = 0;
        EpiG1 E{(bf16_t*)(ws + WS_U), (bf16_t*)(ws + WS_ZS), (bf16_t*)(ws + WS_UF), (bf16_t*)(ws + WS_ZF), (bf16_t*)args.out};
                gp::gemm_phase<gp::RowMajor, gp::RowMajor, TileSched<1>, EpiG1, PG8_ALIGN, PG8_SP2>(lds + RING_OFF, gp::RowMajor{DM}, gp::RowMajor{DM}, S, E);
        if (BOTH(1)) GRID_BAR();
    }

    if (IN(2)) {
        { SsmSched<1> S; S.G = G; S.c = bx; S.U = (const char*)(ws + WS_U); S.E = S.U; S.Bm = (const char*)(ws + WS_ME); S.b_group = (size_t)256 * 256 * 2; S.ksegB = 0;
          EpiSS1 E{(bf16_t*)(ws + WS_E)};
          gp::gemm_phase<gp::RowMajor, gp::RowMajor, SsmSched<1>, EpiSS1, PG8_ALIGN, PG8_SP2>(lds + RING_OFF, gp::RowMajor{256}, gp::RowMajor{256}, S, E); }
        { unsigned* E32 = (unsigned*)(ws + WS_E); const f32x2* LT = (const f32x2*)(ws + WS_LT); int idx = 0;
          for (int i = 0; ; ++i) { const long L = (long)i * G + bx; if (L >= NG * 6) break;
              const int wgid = xcd_remap((int)L, NG * 6), g = wgid / 6, ct = wgid % 6, ntk = ct < 4 ? 4 : 2;
              for (int k = 0; k < ntk; ++k, ++idx) if ((idx & 7) == wave) {
                  if (ct < 4) ss2_scan(E32, LT, g, k & 1, (2 * ct + (k >> 1)) * (LP / TCH), LP / TCH, lane);
                  else ss2_scan(E32, LT, g, k & 1, (MP / TCH) + (ct - 4) * (LS / TCH), LS / TCH, lane); } } }
        { const int gw = vcu * NWAVES + wave, NGW = G * NWAVES;
          for (int t = gw; t < 8 * (LP / 4) + 2 * (LS / 4); t += NGW) fold_task((const bf16_t*)(ws + WS_UF), (bf16_t*)(ws + WS_F), (bf16_t*)(ws + WS_XH), t, lane); }
        if (BOTH(2)) GRID_BAR();
    }

    if (IN(3)) {
        for (int ch = vcu * NWAVES + wave; ch < 2048; ch += G * NWAVES) spec_wave((const bf16_t*)(ws + WS_WFA), (const bf16_t*)(ws + WS_XH), (float*)(ws + WS_SPEC), ch, lane);
        __syncthreads();
        { FaSched S; S.G = G; S.c = bx; S.A = (const char*)(ws + WS_WFA); S.F = (const char*)(ws + WS_F);
          EpiFA E{(bf16_t*)(ws + WS_V)};
          gp::gemm_phase<gp::RowMajor, gp::RowMajor, FaSched, EpiFA, PG8_ALIGN, PG8_SP2>(lds + RING_OFF, gp::RowMajor{FGC}, gp::RowMajor{2048}, S, E); }
        if (BOTH(3)) GRID_BAR();
    }

    if (IN(4)) {
        { FbSched S; S.G = G; S.c = bx; S.T2E = (const char*)(ws + WS_T2E); S.T2O = (const char*)(ws + WS_T2O); S.T4E = (const char*)(ws + WS_T4E); S.T4O = (const char*)(ws + WS_T4O); S.V = (const char*)(ws + WS_V);
          EpiFB E{(const bf16_t*)(ws + WS_ZF), (bf16_t*)(ws + WS_YF), (const float*)(ws + WS_SPEC)};
          gp::gemm_phase<gp::RowMajor, gp::RowMajor, FbSched, EpiFB, PG8_ALIGN, PG8_SP2>(lds + RING_OFF, gp::RowMajor{TLD}, gp::RowMajor{VLD}, S, E); }
        { SsmSched<2> S; S.G = G; S.c = bx; S.U = (const char*)(ws + WS_U); S.E = (const char*)(ws + WS_E); S.Bm = (const char*)(ws + WS_MTF); S.b_group = (size_t)256 * 512 * 2; S.ksegB = 256 * 2;
          EpiSS3 E{(bf16_t*)(ws + WS_YG)};
          gp::gemm_phase<gp::RowMajor, gp::RowMajor, SsmSched<2>, EpiSS3, PG8_ALIGN, PG8_SP2>(lds + RING_OFF, gp::RowMajor{256}, gp::RowMajor{512}, S, E); }
        if (BOTH(4)) GRID_BAR();
    }

    if (IN(5)) {
        TileSched<1> S; S.nM = M / 256; S.nN = 4096 / 256; S.nwg = S.nM * S.nN; S.G = G; S.c = bx;
        S.A0 = (const char*)(ws + WS_YG); S.B0 = (const char*)(ws + WS_WGLU); S.A1 = S.A0; S.B1 = S.B0; S.a_tile = (size_t)256 * 32; S.b_tile = (size_t)256 * 2048 * 2; S.nt0 = 2048 / 64; S.nt1 = 0; S.flags0 = 0;
        EpiG2 E{(const bf16_t*)(ws + WS_ZS), (bf16_t*)(ws + WS_YS)};
        gp::gemm_phase<gp::GroupMajor, gp::RowMajor, TileSched<1>, EpiG2, PG8_ALIGN, PG8_SP2>(lds + RING_OFF, gp::GroupMajor{M}, gp::RowMajor{2048}, S, E);
        if (BOTH(5)) GRID_BAR();
    }

    if (IN(6)) {
        TileSched<2> S; S.nM = M / 256; S.nN = DM / 256; S.nwg = S.nM * S.nN; S.G = G; S.c = bx;
        S.A0 = (const char*)(ws + WS_YS); S.A1 = (const char*)(ws + WS_YF); S.B0 = (const char*)(ws + WS_WUP); S.B1 = S.B0 + 2048 * 2;
        S.a_tile = (size_t)256 * 2048 * 2; S.b_tile = (size_t)256 * 4096 * 2; S.nt0 = 2048 / 64; S.nt1 = 2048 / 64; S.flags0 = gp::F_EPI;
        EpiG3 E{(const bf16_t*)args.out, (bf16_t*)(ws + WS_MG)};
        gp::gemm_phase<gp::RowMajor, gp::RowMajor, TileSched<2>, EpiG3, PG8_ALIGN, PG8_SP2>(lds + RING_OFF, gp::RowMajor{2048}, gp::RowMajor{4096}, S, E);
        if (BOTH(6)) GRID_BAR();
    }

    if (IN(7)) {
        TileSched<1> S; S.nM = M / 256; S.nN = DM / 256; S.nwg = S.nM * S.nN; S.G = G; S.c = bx;
        S.A0 = (const char*)(ws + WS_MG); S.B0 = (const char*)(ws + WS_WOUT); S.A1 = S.A0; S.B1 = S.B0; S.a_tile = (size_t)256 * DM * 2; S.b_tile = (size_t)256 * DM * 2; S.nt0 = DM / 64; S.nt1 = 0; S.flags0 = 0;
        EpiG4 E{(bf16_t*)(ws + WS_OUTB)};
        gp::gemm_phase<gp::RowMajor, gp::RowMajor, TileSched<1>, EpiG4, PG8_ALIGN, PG8_SP2>(lds + RING_OFF, gp::RowMajor{DM}, gp::RowMajor{DM}, S, E);
        if (BOTH(7)) GRID_BAR();
    }

    if (IN(8)) {
        const int gw = vcu * NWAVES + wave, NGW = G * NWAVES;
        for (int m = gw; m < M; m += NGW) { const float* xr = m < MP ? args.in[0] + (size_t)m * DM : args.in[1] + (size_t)(m - MP) * DM;
            final_row((const bf16_t*)(ws + WS_OUTB) + (size_t)m * DM, xr, args.in[3], args.out + (size_t)m * DM, lane); }
    }
#undef IN
#undef BOTH
#undef GRID_BAR
}


extern "C" void kernel_launch(void* const* d_in, const int* in_sizes, int n_in, void* d_out, int out_size, void* d_ws, size_t ws_size, hipStream_t stream) {
    static int grid = 0;
    if (grid == 0) {
        if (n_in != 18 || out_size != M * DM || ws_size < WS_END) { fprintf(stderr, "kernel_launch: built for 18 inputs, %d outputs, >= %zu bytes of workspace; got n_in %d, out %d, ws %zu; nothing launched\n", M * DM, (size_t)WS_END, n_in, out_size, ws_size); grid = -1; return; }
        int dev = 0, cus = 0, per_cu = 0;
        if (hipGetDevice(&dev) != hipSuccess || hipDeviceGetAttribute(&cus, hipDeviceAttributeMultiprocessorCount, dev) != hipSuccess) { fprintf(stderr, "kernel_launch: hipGetDevice / hipDeviceGetAttribute failed\n"); grid = -1; return; }
        if (hipFuncSetAttribute((const void*)hybrid_fwd, hipFuncAttributeMaxDynamicSharedMemorySize, LDS_BYTES) != hipSuccess) { fprintf(stderr, "kernel_launch: hipFuncSetAttribute failed\n"); grid = -1; return; }
        if (hipOccupancyMaxActiveBlocksPerMultiprocessor(&per_cu, (const void*)hybrid_fwd, NWAVES * 64, LDS_BYTES) != hipSuccess || per_cu < 1)
            fprintf(stderr, "kernel_launch: note: occupancy query reports %d workgroups per CU\n", per_cu);
        (void)hipGetLastError();
        grid = cus;
    }
    if (grid < 0) return;
    if (hipMemsetAsync((char*)d_ws + WS_CTL, 0, CTL_ZERO_BYTES, stream) != hipSuccess) { fprintf(stderr, "kernel_launch: hipMemsetAsync failed\n"); return; }
    Args a{};
    for (int i = 0; i < 18; ++i) a.in[i] = (const float*)d_in[i];
    a.out = (float*)d_out; a.ws = (unsigned char*)d_ws;
    if (MK_N_LAUNCHES == 1) { a.ph_lo = 0; a.ph_hi = N_PHASES; hipLaunchKernelGGL(hybrid_fwd, dim3(grid), dim3(NWAVES * 64), LDS_BYTES, stream, a); }
    else for (int p = 0; p < N_PHASES; ++p) { a.ph_lo = p; a.ph_hi = p + 1; hipLaunchKernelGGL(hybrid_fwd, dim3(grid), dim3(NWAVES * 64), LDS_BYTES, stream, a);
    }
    const hipError_t le = hipPeekAtLastError();
    if (le != hipSuccess) fprintf(stderr, "kernel_launch: launch failed: %s\n", hipGetErrorName(le));
}
```

```cpp
#define MK_N_LAUNCHES 1
#include <hip/hip_runtime.h>
#include <cstdio>
#include <cstdint>

#define GAS __attribute__((address_space(1)))
#define LAS __attribute__((address_space(3)))
typedef unsigned short bf16_t;
typedef short bf16x8 __attribute__((ext_vector_type(8)));
typedef float f32x4 __attribute__((ext_vector_type(4)));
typedef float f32x2 __attribute__((ext_vector_type(2)));
typedef unsigned u32x4 __attribute__((ext_vector_type(4)));
typedef unsigned u32x2 __attribute__((ext_vector_type(2)));

namespace gp {
constexpr int BM = 256, BK = 64, HALF = 128, HTB = HALF * BK * 2  , STAGE_BYTES = 8 * HTB;

__host__ __device__ __forceinline__ int lds_byte(int r, int c) { const int st = (r >> 4) * 2 + (c >> 5), rr = r & 15, cc = c & 31, ob = rr * 64 + cc * 2; return st * 1024 + (ob ^ (((ob >> 9) & 1) << 5)); }
__host__ __device__ __forceinline__ void stage_rc(int b, int& R, int& C) { const int st = b / 1024, sb = b % 1024, swz = sb ^ (((sb >> 9) & 1) << 5); R = (st >> 1) * 16 + swz / 64; C = (st & 1) * 32 + (swz % 64) / 2; }
__host__ __device__ __forceinline__ int perm32(int rho) { const int n = rho >> 4, i = rho & 15; return 8 * (i >> 2) + 4 * n + (i & 3); }

struct SU { const char* A; const char* B; int nt; int flags; int pm; int pn; };
enum { F_EPI = 1, F_ZERO = 2, F_SEG1 = 4 };

struct RowMajor { static constexpr int AUX = 0; int ld; __device__ __forceinline__ unsigned off(int R, int C) const { return (unsigned)(R * ld + C) * 2u; }
    __device__ __forceinline__ size_t kstep() const { return (size_t)BK * 2; } __device__ __forceinline__ size_t hstep() const { return (size_t)HALF * ld * 2; } };
struct GroupMajor { static constexpr int AUX = 0; int rows; __device__ __forceinline__ unsigned off(int R, int C) const { return (unsigned)(C >> 4) * (unsigned)(rows * 32) + (unsigned)(R * 32 + (C & 15) * 2); }
    __device__ __forceinline__ size_t kstep() const { return (size_t)4 * rows * 32; } __device__ __forceinline__ size_t hstep() const { return (size_t)HALF * 32; } };

typedef __bf16 bf16x2_t __attribute__((ext_vector_type(2)));
__device__ __forceinline__ unsigned cvt_pk_bf16(float lo, float hi) { const f32x2 v = {lo, hi}; return __builtin_bit_cast(unsigned, __builtin_convertvector(v, bf16x2_t)); }
__device__ __forceinline__ u32x4 pack8(const f32x4 a, const f32x4 b) { u32x4 w; w.x = cvt_pk_bf16(a[0], a[1]); w.y = cvt_pk_bf16(a[2], a[3]); w.z = cvt_pk_bf16(b[0], b[1]); w.w = cvt_pk_bf16(b[2], b[3]); return w; }
__device__ __forceinline__ float bf_lo(unsigned w) { return __uint_as_float(w << 16); }
__device__ __forceinline__ float bf_hi(unsigned w) { return __uint_as_float(w & 0xffff0000u); }
__device__ __forceinline__ void unpack8(const u32x4 w, f32x4& a, f32x4& b) { a = (f32x4){bf_lo(w.x), bf_hi(w.x), bf_lo(w.y), bf_hi(w.y)}; b = (f32x4){bf_lo(w.z), bf_hi(w.z), bf_lo(w.w), bf_hi(w.w)}; }
__device__ __forceinline__ float sigmoidf_(float x) { return __builtin_amdgcn_rcpf(1.0f + __builtin_amdgcn_exp2f(-1.44269504089f * x)); }
__device__ __forceinline__ float siluf_(float x) { return x * sigmoidf_(x); }
__device__ __forceinline__ float gelu_tanh_(float x) { const float z = x + 0.044715f * x * x * x; return x * __builtin_amdgcn_rcpf(1.0f + __builtin_amdgcn_exp2f(-2.30220819813f * z)); }
__device__ __forceinline__ void sigmoid2_(float a, float b, float& sa, float& sb) {
    const float ea = 1.0f + fminf(__builtin_amdgcn_exp2f(-1.44269504089f * a), 1e18f), eb = 1.0f + fminf(__builtin_amdgcn_exp2f(-1.44269504089f * b), 1e18f);
    const float ip = __builtin_amdgcn_rcpf(ea * eb); sa = ip * eb; sb = ip * ea; }
template <int ACT> __device__ __forceinline__ f32x4 act4(f32x4 v) {
    if (ACT == 1) { float s0, s1, s2, s3; sigmoid2_(v[0], v[1], s0, s1); sigmoid2_(v[2], v[3], s2, s3); return v * (f32x4){s0, s1, s2, s3}; }
    if (ACT == 2) { float s0, s1, s2, s3; sigmoid2_(v[0], v[1], s0, s1); sigmoid2_(v[2], v[3], s2, s3); return (f32x4){s0, s1, s2, s3}; }
    if (ACT == 3) { return (f32x4){gelu_tanh_(v[0]), gelu_tanh_(v[1]), gelu_tanh_(v[2]), gelu_tanh_(v[3])}; }
    return v;
}
__device__ __forceinline__ unsigned opaque_u(unsigned v) { asm volatile("" : "+v"(v)); return v; }
template <int ACT> __device__ __forceinline__ void store_tile(const f32x4 (&acc)[2][2][4][2], bf16_t* O, unsigned ld, int wr, int wc, int fr, int fq) {
    const unsigned lo = opaque_u((unsigned)(wr * 64 + fr) * ld + (unsigned)(wc * 32 + 8 * fq));
#pragma unroll
    for (int ai = 0; ai < 2; ++ai)
#pragma unroll
        for (int m = 0; m < 4; ++m) { bf16_t* rowp = O + (size_t)(ai * HALF + m * 16) * ld;
#pragma unroll
            for (int bj = 0; bj < 2; ++bj) *(u32x4*)(rowp + bj * HALF + lo) = pack8(act4<ACT>(acc[ai][bj][m][0]), act4<ACT>(acc[ai][bj][m][1])); }
}

template <class AddrA, class AddrB, class Sched, class Epi, bool ALIGN_EPI, bool SP2>
__device__ __forceinline__ void gemm_phase(LAS unsigned char* lds, const AddrA aA, const AddrB aB, const Sched& S, const Epi& E) {
    int tid_ = threadIdx.x; asm volatile("" : "+v"(tid_));
    const int tid = tid_, wid = __builtin_amdgcn_readfirstlane(tid >> 6), lane = tid & 63, wr = wid >> 2, wc = wid & 3, fr = lane & 15, fq = lane >> 4;
    unsigned voffA[2], voffB[2];
#pragma unroll
    for (int i = 0; i < 2; ++i) { int R, C; stage_rc(tid * 16 + i * 8192, R, C); const int Rb = (R & ~31) + perm32(R & 31);
        voffA[i] = aA.off(R, C); voffB[i] = aB.off(Rb, C); }
    const size_t kstepA = aA.kstep(), kstepB = aB.kstep(), hstepA = aA.hstep(), hstepB = aB.hstep();
    const unsigned ldsw = (unsigned)wid * 1024u;
    const int aoff = lds_byte(wr * 64 + fr, fq * 8), boff = lds_byte(wc * 32 + fr, fq * 8);
#define PG8_SA(b, h) (((b) * 2 + (h)) * HTB)
#define PG8_SB(b, h) ((4 + (b) * 2 + (h)) * HTB)
#define PG8_STAGE(bufoff, gbase, voff) do { _Pragma("unroll") for (int _i = 0; _i < 2; ++_i) \
        __builtin_amdgcn_global_load_lds((const unsigned*)((const char*)(gbase) + (voff)[_i]), (LAS unsigned*)(lds + (bufoff) + ldsw + _i * 8192), 16, 0, 0); } while (0)
#define PG8_STAGEB(bufoff, gbase, voff) do { _Pragma("unroll") for (int _i = 0; _i < 2; ++_i) \
        __builtin_amdgcn_global_load_lds((const unsigned*)((const char*)(gbase) + (voff)[_i]), (LAS unsigned*)(lds + (bufoff) + ldsw + _i * 8192), 16, 0, AddrB::AUX); } while (0)
#define PG8_LDA(dst, b, h) do { _Pragma("unroll") for (int m = 0; m < 4; ++m) _Pragma("unroll") for (int k = 0; k < 2; ++k) dst[m][k] = *(const LAS bf16x8*)(lds + PG8_SA(b, h) + aoff + m * 2048 + k * 1024); } while (0)
#define PG8_LDB(dst, b, h) do { _Pragma("unroll") for (int n = 0; n < 2; ++n) _Pragma("unroll") for (int k = 0; k < 2; ++k) dst[n][k] = *(const LAS bf16x8*)(lds + PG8_SB(b, h) + boff + n * 2048 + k * 1024); } while (0)
#define PG8_MMA(ai, bj, At, Bt) do { __builtin_amdgcn_s_setprio(1); _Pragma("unroll") for (int m = 0; m < 4; ++m) _Pragma("unroll") for (int n = 0; n < 2; ++n) _Pragma("unroll") for (int k = 0; k < 2; ++k) \
        acc[ai][bj][m][n] = __builtin_amdgcn_mfma_f32_16x16x32_bf16(Bt[n][k], At[m][k], acc[ai][bj][m][n], 0, 0, 0); __builtin_amdgcn_s_setprio(0); } while (0)
#define PG8_WAIT_V(n) asm volatile("s_waitcnt vmcnt(" #n ")" ::: "memory")
#define PG8_WAIT_L(n) asm volatile("s_waitcnt lgkmcnt(" #n ")" ::: "memory")
#define PG8_BAR __builtin_amdgcn_s_barrier()
#define PG8_SCHED __builtin_amdgcn_sched_barrier(0)
    SU cur, nxt; int ui = 0;
    if (!S.next(0, cur)) return;
    f32x4 acc[2][2][4][2];
#pragma unroll
    for (int a = 0; a < 2; ++a)
#pragma unroll
        for (int b = 0; b < 2; ++b)
#pragma unroll
            for (int m = 0; m < 4; ++m)
#pragma unroll
                for (int n = 0; n < 2; ++n) acc[a][b][m][n] = (f32x4){0.f, 0.f, 0.f, 0.f};
    bf16x8 At[4][2], B0[2][2], B1[2][2];
    const char* cA = cur.A; const char* cB = cur.B;
    if constexpr (SP2) {
        PG8_STAGEB(PG8_SB(0, 0), cB, voffB); PG8_STAGEB(PG8_SB(0, 1), cB + hstepB, voffB); PG8_STAGE(PG8_SA(0, 0), cA, voffA); PG8_STAGE(PG8_SA(0, 1), cA + hstepA, voffA);
        if (wr == 1) PG8_BAR;
        PG8_WAIT_V(2); PG8_BAR;
        PG8_STAGEB(PG8_SB(1, 0), cB + kstepB, voffB); PG8_STAGE(PG8_SA(1, 0), cA + kstepA, voffA); PG8_STAGEB(PG8_SB(1, 1), cB + hstepB + kstepB, voffB);
        PG8_WAIT_V(6); PG8_BAR;
    } else {
        PG8_STAGEB(PG8_SB(0, 0), cB, voffB); PG8_STAGE(PG8_SA(0, 0), cA, voffA); PG8_STAGEB(PG8_SB(0, 1), cB + hstepB, voffB); PG8_STAGE(PG8_SA(0, 1), cA + hstepA, voffA);
        if (wr == 1) PG8_BAR;
        PG8_WAIT_V(4); PG8_BAR;
        PG8_STAGEB(PG8_SB(1, 0), cB + kstepB, voffB); PG8_STAGE(PG8_SA(1, 0), cA + kstepA, voffA); PG8_STAGEB(PG8_SB(1, 1), cB + hstepB + kstepB, voffB);
        PG8_WAIT_V(6); PG8_BAR;
    }
    for (;;) {
        const bool has_next = S.next(ui + 1, nxt);
        const char* nA = has_next ? nxt.A : cA; const char* nB = has_next ? nxt.B : cB;
        int nt = cur.nt; asm volatile("" : "+s"(nt));
        for (int t = 0; t < nt; t += 2) {
            const bool last = (t == nt - 2);
            const char* a1 = cA + (size_t)(t + 1) * kstepA;
            const char* a2 = last ? nA : cA + (size_t)(t + 2) * kstepA; const char* b2 = last ? nB : cB + (size_t)(t + 2) * kstepB;
            const char* a3 = a2 + kstepA; const char* b3 = b2 + kstepB;
            if constexpr (SP2) {
            PG8_LDB(B0, 0, 0); PG8_LDB(B1, 0, 1); PG8_SCHED; PG8_LDA(At, 0, 0); PG8_STAGE(PG8_SA(1, 1), a1 + hstepA, voffA);
            PG8_WAIT_V(8); PG8_WAIT_L(0); PG8_BAR; PG8_MMA(0, 0, At, B0); PG8_MMA(0, 1, At, B1); PG8_BAR; PG8_SCHED;
            PG8_LDA(At, 0, 1); PG8_STAGEB(PG8_SB(0, 0), b2, voffB); PG8_STAGEB(PG8_SB(0, 1), b2 + hstepB, voffB); PG8_STAGE(PG8_SA(0, 0), a2, voffA);
            PG8_WAIT_V(8); PG8_WAIT_L(0); PG8_BAR; PG8_MMA(1, 0, At, B0); PG8_MMA(1, 1, At, B1); PG8_BAR; PG8_SCHED;
            PG8_LDB(B0, 1, 0); PG8_LDB(B1, 1, 1); PG8_SCHED; PG8_LDA(At, 1, 0); PG8_STAGE(PG8_SA(0, 1), a2 + hstepA, voffA);
            PG8_WAIT_V(8); PG8_WAIT_L(0); PG8_BAR; PG8_MMA(0, 0, At, B0); PG8_MMA(0, 1, At, B1); PG8_BAR; PG8_SCHED;
            PG8_LDA(At, 1, 1); PG8_STAGEB(PG8_SB(1, 0), b3, voffB); PG8_STAGEB(PG8_SB(1, 1), b3 + hstepB, voffB); PG8_STAGE(PG8_SA(1, 0), a3, voffA);
            PG8_WAIT_V(8); PG8_WAIT_L(0); PG8_BAR; PG8_MMA(1, 0, At, B0); PG8_MMA(1, 1, At, B1); PG8_BAR; PG8_SCHED;
            } else {
            PG8_LDB(B0, 0, 0); PG8_SCHED; PG8_LDA(At, 0, 0); PG8_STAGE(PG8_SA(1, 1), a1 + hstepA, voffA);
            PG8_WAIT_L(8); PG8_BAR; PG8_WAIT_L(0); PG8_MMA(0, 0, At, B0); PG8_BAR; PG8_SCHED;
            PG8_LDB(B1, 0, 1); PG8_STAGEB(PG8_SB(0, 0), b2, voffB);
            PG8_BAR; PG8_WAIT_L(0); PG8_MMA(0, 1, At, B1); PG8_BAR;
            PG8_LDA(At, 0, 1); PG8_STAGE(PG8_SA(0, 0), a2, voffA);
            PG8_BAR; PG8_WAIT_L(0); PG8_MMA(1, 0, At, B0); PG8_BAR; PG8_SCHED;
            PG8_STAGEB(PG8_SB(0, 1), b2 + hstepB, voffB);
            PG8_WAIT_V(6); PG8_BAR; PG8_MMA(1, 1, At, B1); PG8_BAR;
            PG8_LDB(B0, 1, 0); PG8_SCHED; PG8_LDA(At, 1, 0); PG8_STAGE(PG8_SA(0, 1), a2 + hstepA, voffA);
            PG8_WAIT_L(8); PG8_BAR; PG8_WAIT_L(0); PG8_MMA(0, 0, At, B0); PG8_BAR; PG8_SCHED;
            PG8_LDB(B1, 1, 1); PG8_STAGEB(PG8_SB(1, 0), b3, voffB);
            PG8_BAR; PG8_WAIT_L(0); PG8_MMA(0, 1, At, B1); PG8_BAR;
            PG8_LDA(At, 1, 1); PG8_STAGE(PG8_SA(1, 0), a3, voffA);
            PG8_BAR; PG8_WAIT_L(0); PG8_MMA(1, 0, At, B0); PG8_BAR; PG8_SCHED;
            PG8_STAGEB(PG8_SB(1, 1), b3 + hstepB, voffB);
            PG8_WAIT_V(6); PG8_BAR; PG8_MMA(1, 1, At, B1); PG8_BAR;
            }
        }
        const bool epi = (cur.flags & F_EPI) != 0;
        if (epi) { if constexpr (ALIGN_EPI) { if (wr == 0) PG8_BAR; }
            E(acc, cur, wr, wc, fr, fq); }
        if (!has_next) break;
        if (cur.flags & F_ZERO) {
#pragma unroll
            for (int a = 0; a < 2; ++a)
#pragma unroll
                for (int b = 0; b < 2; ++b)
#pragma unroll
                    for (int m = 0; m < 4; ++m)
#pragma unroll
                        for (int n = 0; n < 2; ++n) acc[a][b][m][n] = (f32x4){0.f, 0.f, 0.f, 0.f};
        }
        cur = nxt; cA = nA; cB = nB; ++ui;
        if constexpr (ALIGN_EPI) { if (epi && wr == 1) PG8_BAR; }
    }
    PG8_WAIT_V(0);
    if constexpr (!ALIGN_EPI) { if (wr == 0) PG8_BAR; }
    PG8_BAR;
#undef PG8_SA
#undef PG8_SB
#undef PG8_STAGE
#undef PG8_STAGEB
#undef PG8_LDA
#undef PG8_LDB
#undef PG8_MMA
#undef PG8_WAIT_V
#undef PG8_WAIT_L
#undef PG8_BAR
#undef PG8_SCHED
}
}
#define XB_TMO      128
#define XB_XCNT(j)  (256  + 64 * (j))
#define XB_XSUB(j)  (1280 + 64 * (j))
#define XB_XGEN(j)  (2304 + 64 * (j))
#define XB_TOP      3328
#define XB_TOPGEN   3392
#define XCD_BAR_WORDS 3456
#define XB_SPIN_CAP (1u << 18)

__device__ __forceinline__ unsigned xb_ld(unsigned* p)              { return __hip_atomic_load(p, __ATOMIC_RELAXED, __HIP_MEMORY_SCOPE_AGENT); }
__device__ __forceinline__ unsigned xb_add(unsigned* p, unsigned v) { return __hip_atomic_fetch_add(p, v, __ATOMIC_RELAXED, __HIP_MEMORY_SCOPE_AGENT); }
__device__ __forceinline__ unsigned xb_xcc_id() { return (unsigned)__builtin_amdgcn_s_getreg((3 << 11) | 20) & 0xFu; }
#define XB_SPIN(cond, bar) do { unsigned _sp = 0; while (cond) { __builtin_amdgcn_s_sleep(1); \
    if ((++_sp & 255u) == 0u) { if (xb_ld(&(bar)[XB_TMO])) break; if (_sp > XB_SPIN_CAP) { atomicAdd(&(bar)[XB_TMO], 1u); break; } } } } while (0)

struct XcdBarrier {
    unsigned* bar; unsigned x;
    volatile LAS unsigned* st;
};

__device__ __forceinline__ XcdBarrier xcd_barrier_post(unsigned* bar, volatile LAS unsigned* st) {
    XcdBarrier b; b.bar = bar; b.x = xb_xcc_id(); b.st = st;
    if (threadIdx.x == 0) (void)xb_add(&bar[XB_XCNT(b.x)], 1u);
    return b;
}
__device__ __forceinline__ void xcd_barrier_complete(unsigned* bar, unsigned x, unsigned& nloc, unsigned& nx) {
    const unsigned G = gridDim.x * gridDim.y * gridDim.z;
    unsigned sum, cnt, mine, sp = 0u;
    for (;;) {
        sum = 0u; cnt = 0u; mine = 0u;
#pragma unroll
        for (unsigned j = 0; j < 16; ++j) { const unsigned c = xb_ld(&bar[XB_XCNT(j)]); sum += c; cnt += (c > 0u) ? 1u : 0u; mine = (j == x) ? c : mine; }
        if (sum == G) break;
        __builtin_amdgcn_s_sleep(1);
        if ((++sp & 255u) == 0u) { if (xb_ld(&bar[XB_TMO])) break; if (sp > XB_SPIN_CAP) { atomicAdd(&bar[XB_TMO], 1u); break; } }
    }
    nloc = mine > 0u ? mine : 1u; nx = cnt > 0u ? cnt : 1u;
}

__device__ __forceinline__ void xcd_barrier(const XcdBarrier& b) {
    asm volatile("s_waitcnt vmcnt(0)" ::: "memory");
    __syncthreads();
    if (threadIdx.x == 0) {
        unsigned* bar = b.bar;
        __builtin_amdgcn_s_waitcnt(0);
        unsigned nloc = b.st[0], nx = b.st[1];
        if (nloc == 0u) { xcd_barrier_complete(bar, b.x, nloc, nx); b.st[0] = nloc; b.st[1] = nx; }
        const unsigned old = xb_add(&bar[XB_XSUB(b.x)], 1u);
        const unsigned gen = old / nloc;
        if (old + 1u == (gen + 1u) * nloc) {
            __builtin_amdgcn_fence(__ATOMIC_RELEASE, "agent");
            asm volatile("s_waitcnt vmcnt(0)" ::: "memory");
            const unsigned og = xb_add(&bar[XB_TOP], 1u);
            const unsigned tg = og / nx;
            if (og + 1u == (tg + 1u) * nx) xb_add(&bar[XB_TOPGEN], 1u);
            else XB_SPIN(xb_ld(&bar[XB_TOPGEN]) == tg, bar);
            __builtin_amdgcn_fence(__ATOMIC_ACQUIRE, "agent");
            xb_add(&bar[XB_XGEN(b.x)], 1u);
            asm volatile("s_waitcnt vmcnt(0)" ::: "memory");
        } else {
            XB_SPIN(xb_ld(&bar[XB_XGEN(b.x)]) == gen, bar);
            __builtin_amdgcn_fence(__ATOMIC_ACQUIRE, "agent");
            asm volatile("s_waitcnt vmcnt(0)" ::: "memory");
        }
    }
    __syncthreads();
}


constexpr int NWAVES = 8;
constexpr int DM = 4096;
constexpr int LP = 2048, LS = 4096;
constexpr int MP = 8 * LP, MS = 2 * LS, M = MP + MS;
constexpr int NIN = 16384;
constexpr int NG = 128, PS = 64, TCH = 16, NCH = M / TCH;
constexpr int ESTR = NCH + 9;
constexpr int FGC = 512;
constexpr float RMS_EPS = 1e-6f;
constexpr int TLD = 2048;
constexpr int NP_ = LP / 2, NS_ = LS / 2;
constexpr int VLD = M;

constexpr size_t MiB = 1u << 20;
constexpr size_t WS_CTL = 0, CTL_ZERO_BYTES = 1 * MiB;
constexpr size_t WS_LT = 1 * MiB;
constexpr size_t WS_WGLU = 2 * MiB, WS_WUP = 18 * MiB, WS_WOUT = 50 * MiB, WS_WFA = 82 * MiB;
constexpr size_t WS_T2E = 86 * MiB, WS_T2O = 90 * MiB, WS_T4E = 94 * MiB, WS_T4O = 102 * MiB;
constexpr size_t WS_ME = 110 * MiB, WS_MTF = 126 * MiB;
constexpr size_t WS_A = 158 * MiB;
constexpr size_t WS_H = WS_A;
constexpr size_t WS_WIN = 350 * MiB;
constexpr size_t WS_E = 350 * MiB;
constexpr size_t WS_YS = WS_E;
constexpr size_t WS_F = 447 * MiB;
constexpr size_t WS_YF = WS_F;
constexpr size_t WS_U = 543 * MiB, WS_ZS = 639 * MiB;
constexpr size_t WS_MG = WS_U;
constexpr size_t WS_UF = 735 * MiB;
constexpr size_t WS_V = WS_UF;
constexpr size_t WS_ZF = 831 * MiB;
constexpr size_t WS_OUTB = WS_UF;
constexpr size_t WS_YG = 927 * MiB;
constexpr size_t WS_END = 1023 * MiB;
constexpr size_t WS_RMS = WS_LT + 640 * 1024;
constexpr size_t WS_SPEC = WS_LT + 256 * 1024, WS_XH = WS_LT + 512 * 1024;
constexpr int CW_TMO = 0;
constexpr int CW_BAR = 4096;

constexpr int RING_OFF = 0, RING_BYTES = 131072;
constexpr int MISC_OFF = RING_BYTES;
constexpr int XTRA_OFF = MISC_OFF + 512;
constexpr int LDS_BYTES = 147456;

struct Args { const float* in[18]; float* out; unsigned char* ws; int ph_lo, ph_hi; };

__device__ __forceinline__ float wave_sum(float v) {
#pragma unroll
    for (int o = 1; o < 64; o <<= 1) v += __shfl_xor(v, o);
    return v;
}
#define LDS_WAIT() asm volatile("s_waitcnt lgkmcnt(0)" ::: "memory")
__device__ __forceinline__ unsigned pk2(float lo, float hi) { return gp::cvt_pk_bf16(lo, hi); }
__device__ __forceinline__ f32x2 cmul(f32x2 a, f32x2 b) { return (f32x2){a.x * b.x - a.y * b.y, a.x * b.y + a.y * b.x}; }

__device__ __forceinline__ void p0_transpose_item(const float* W, int N, bf16_t* WT, size_t ldo, int kcol0, int k0, int n0, int orow0, LAS float* scr, int lane, float sc = 1.0f, const float* gk = nullptr) {
    float wv[32];
#pragma unroll
    for (int i = 0; i < 32; ++i) wv[i] = W[(size_t)(k0 + 2 * i + (lane >> 5)) * N + n0 + (lane & 31)];
#pragma unroll
    for (int i = 0; i < 32; ++i) scr[(2 * i + (lane >> 5)) * 33 + (lane & 31)] = wv[i];
    LDS_WAIT(); asm volatile("" ::: "memory");
    const int c = lane & 7;
    f32x4 ga = (f32x4){sc, sc, sc, sc}, gb = ga;
    if (gk) { ga *= *(const f32x4*)(gk + k0 + 8 * c); gb *= *(const f32x4*)(gk + k0 + 8 * c + 4); }
#pragma unroll
    for (int j = 0; j < 4; ++j) { const int n = (lane >> 3) + 8 * j; const LAS float* s = scr + (8 * c) * 33 + n;
        u32x4 o; o.x = pk2(s[0 * 33] * ga[0], s[1 * 33] * ga[1]); o.y = pk2(s[2 * 33] * ga[2], s[3 * 33] * ga[3]); o.z = pk2(s[4 * 33] * gb[0], s[5 * 33] * gb[1]); o.w = pk2(s[6 * 33] * gb[2], s[7 * 33] * gb[3]);
        *(u32x4*)(WT + (size_t)(orow0 + n) * ldo + kcol0 + k0 + 8 * c) = o; }
    LDS_WAIT(); asm volatile("" ::: "memory");
}
__device__ __forceinline__ void rms_row_to_bf16(const float* xrow, bf16_t* orow, float* rms_out, int lane) {
    const f32x4* xr = (const f32x4*)xrow + lane;
    f32x4 v[16]; float s = 0.f;
#pragma unroll
    for (int j = 0; j < 16; ++j) { v[j] = xr[64 * j]; s += (v[j].x * v[j].x + v[j].y * v[j].y) + (v[j].z * v[j].z + v[j].w * v[j].w); }
    const float rms = sqrtf(wave_sum(s) * (1.f / DM) + RMS_EPS), r = 1.0f / rms;
    u32x2* o8 = (u32x2*)orow + lane;
#pragma unroll
    for (int j = 0; j < 16; ++j) { u32x2 w; w.x = pk2(v[j].x * r, v[j].y * r); w.y = pk2(v[j].z * r, v[j].w * r); o8[64 * j] = w; }
    if (lane == 0) *rms_out = rms;
}
__device__ __forceinline__ void p0_ssm_group(const Args& a, int g, LAS unsigned char* lds, int tid) {
    LAS f32x2* pw = (LAS f32x2*)lds;
    LAS f32x2* bb = (LAS f32x2*)(lds + 17408);
    LAS f32x2* cm = (LAS f32x2*)(lds + 33792);
    LAS float* Kt = (LAS float*)(lds + 50176);
    const float* lam_re = a.in[5]; const float* lam_im = a.in[6]; const float* log_dt = a.in[7];
    const float* b_re = a.in[8]; const float* b_im = a.in[9]; const float* c_re = a.in[10]; const float* c_im = a.in[11]; const float* dsk = a.in[12];
    bf16_t* ME = (bf16_t*)(a.ws + WS_ME) + (size_t)g * 256 * 256; bf16_t* MTF = (bf16_t*)(a.ws + WS_MTF) + (size_t)g * 256 * 512; f32x2* LT = (f32x2*)(a.ws + WS_LT);
    LAS f32x2* qd = (LAS f32x2*)(lds + 82944);
    { const int d = (tid >> 6) & 1, p = tid & 63, eq = tid >> 7;
        const float lre = fminf(lam_re[(d * NG + g) * PS + p], -1e-4f), lim = lam_im[(d * NG + g) * PS + p], dt = expf(log_dt[d * NG + g]);
#pragma unroll
        for (int k = 1; k <= 4; ++k) { const int e = eq * 4 + k; const float mag = expf(lre * dt * (float)e); float s, c; sincosf(lim * dt * (float)e, &s, &c); pw[(d * 17 + e) * 64 + p] = (f32x2){mag * c, mag * s};
            if (e == 16) LT[(g * 2 + d) * 64 + p] = (f32x2){mag * c, mag * s}; }
        if (eq == 0) { pw[(d * 17) * 64 + p] = (f32x2){1.f, 0.f};
            const float ar = lre * dt, ai = lim * dt; float sh = sinf(0.5f * ai), s, co; sincosf(ai, &s, &co);
            const float nr = expm1f(ar) * co - 2.f * sh * sh, ni = expf(ar) * s, den = lre * lre + lim * lim;
            qd[d * 64 + p] = (f32x2){(nr * lre + ni * lim) / den, (ni * lre - nr * lim) / den}; }
    }
#pragma unroll
    for (int j = 0; j < 4; ++j) { const int idx = tid + 512 * j;
        const int d = idx >> 10, c = (idx >> 6) & 15, p = idx & 63; const size_t ci = ((size_t)(d * NG + g) * 16 + c) * PS + p;
        cm[(d * 16 + c) * 64 + p] = (f32x2){c_re[ci], c_im[ci]}; }
    __syncthreads();
#pragma unroll
    for (int j = 0; j < 4; ++j) { const int idx = tid + 512 * j;
        const int d = idx >> 10, p = (idx >> 4) & 63, c = idx & 15;
        const size_t bi = ((size_t)(d * NG + g) * PS + p) * 16 + c;
        bb[(d * 64 + p) * 16 + c] = cmul(qd[d * 64 + p], (f32x2){b_re[bi], b_im[bi]}); }
    __syncthreads();
    { const int d = tid >> 8, e = (tid >> 4) & 15, c = tid & 15; float acc[16];
#pragma unroll
      for (int q = 0; q < 16; ++q) acc[q] = 0.f;
      for (int p = 0; p < 64; ++p) { const f32x2 Gm = cmul(cm[(d * 16 + c) * 64 + p], pw[(d * 17 + e) * 64 + p]);
#pragma unroll
          for (int q = 0; q < 16; ++q) { const f32x2 b = bb[(d * 64 + p) * 16 + q]; acc[q] += Gm.x * b.x - Gm.y * b.y; } }
#pragma unroll
      for (int q = 0; q < 16; ++q) Kt[((d * 16 + e) * 16 + c) * 16 + q] = acc[q];
    }
    __syncthreads();
    for (int j = 0; j < 16; ++j) { const int q = tid + 512 * j, row = q >> 5, o = q & 31, col0 = o * 8;
        {
            const int i = row >> 4, c = row & 15, jj = col0 >> 4, cq0 = col0 & 15; float v[8];
#pragma unroll
            for (int k = 0; k < 8; ++k) { const int cq = cq0 + k; float x = 0.f;
                if (jj <= i) x += Kt[((0 * 16 + (i - jj)) * 16 + c) * 16 + cq];
                if (jj >= i) x += Kt[((1 * 16 + (jj - i)) * 16 + c) * 16 + cq];
                if (jj == i && cq == c) x += dsk[16 * g + c];
                v[k] = x; }
            u32x4 w; w.x = pk2(v[0], v[1]); w.y = pk2(v[2], v[3]); w.z = pk2(v[4], v[5]); w.w = pk2(v[6], v[7]);
            *(u32x4*)(MTF + (size_t)row * 512 + col0) = w; }
        {
            const int i = row >> 4, c = row & 15, d = col0 >> 7, p0 = (col0 & 127) >> 1, e = d == 0 ? i + 1 : 16 - i; unsigned w[4];
#pragma unroll
            for (int k = 0; k < 4; ++k) { const f32x2 Gm = cmul(cm[(d * 16 + c) * 64 + p0 + k], pw[(d * 17 + e) * 64 + p0 + k]); w[k] = pk2(Gm.x, -Gm.y); }
            *(u32x4*)(MTF + (size_t)row * 512 + 256 + col0) = (u32x4){w[0], w[1], w[2], w[3]}; }
        {
            const int d = row >> 7, p = (row & 127) >> 1, im = row & 1, jj = col0 >> 4, cq0 = col0 & 15, e = d == 0 ? 15 - jj : jj; float v[8];
            const f32x2 pe = pw[(d * 17 + e) * 64 + p];
#pragma unroll
            for (int k = 0; k < 8; ++k) { const f32x2 Q = cmul(pe, bb[(d * 64 + p) * 16 + cq0 + k]); v[k] = im ? Q.y : Q.x; }
            u32x4 w; w.x = pk2(v[0], v[1]); w.y = pk2(v[2], v[3]); w.z = pk2(v[4], v[5]); w.w = pk2(v[6], v[7]);
            *(u32x4*)(ME + (size_t)row * 256 + col0) = w; }
    }
    __syncthreads();
}
__device__ __forceinline__ void p0_wfa_task(const float* Wf, bf16_t* WFA, const LAS f32x2* trig, int task, int lane) {
    const int g = task >> 9, c = ((task >> 6) & 7) * 64 + lane, d0 = (task & 63) * 8;
    float ac[8], as[8];
#pragma unroll
    for (int j = 0; j < 8; ++j) { ac[j] = 0.f; as[j] = 0.f; }
    const float* wp = Wf + (size_t)g * FGC * FGC + d0; int idx = 0;
#pragma unroll 4
    for (int cp = 0; cp < FGC; ++cp) { const f32x2 t = trig[idx]; idx = (idx + c) & 511;
        const f32x4 w0 = *(const f32x4*)(wp + (size_t)cp * FGC), w1 = *(const f32x4*)(wp + (size_t)cp * FGC + 4);
#pragma unroll
        for (int j = 0; j < 4; ++j) { ac[j] += t.x * w0[j]; as[j] += t.y * w0[j]; ac[4 + j] += t.x * w1[j]; as[4 + j] += t.y * w1[j]; } }
    const float sc = 0.04419417382f;
#pragma unroll
    for (int j = 0; j < 8; ++j) { WFA[((size_t)(g * 1024 + d0 + j)) * FGC + c] = (bf16_t)(pk2(ac[j] * sc, 0.f) & 0xffffu); WFA[((size_t)(g * 1024 + 512 + d0 + j)) * FGC + c] = (bf16_t)(pk2(as[j] * sc, 0.f) & 0xffffu); }
}
template <int ODD> __device__ __forceinline__ u32x4 dft_piece(int k, int j0, int N, float rs) {
    float v[8]; const int H = N >> 1, Lm = ODD ? 2 * N : N, mul = ODD ? 2 * k + 1 : k; const float inv = 1.0f / (float)Lm;
#pragma unroll
    for (int jj = 0; jj < 8; ++jj) { const int j = j0 + jj, n = j < H ? j : j - H; const float fr = (float)((mul * n) & (Lm - 1)) * inv;
        v[jj] = j < H ? __builtin_amdgcn_cosf(fr) * rs : (j == H ? (ODD ? ((k & 1) ? rs : -rs) : 0.f) : -__builtin_amdgcn_sinf(fr) * rs); }
    u32x4 w; w.x = pk2(v[0], v[1]); w.y = pk2(v[2], v[3]); w.z = pk2(v[4], v[5]); w.w = pk2(v[6], v[7]); return w;
}

constexpr int I_IN = (DM / 64) * (NIN / 32), I_GLU = (2048 / 64) * (4096 / 32), I_UP = (2048 / 64) * (4096 / 32), I_OUT = (DM / 64) * (DM / 32);
constexpr int P0_NITEMS = I_IN + I_GLU + 2 * I_UP + I_OUT;
__device__ __forceinline__ void p0_transpose_dispatch(const Args& a, int r, LAS float* scr, int lane) {
        if (r < I_IN) { const int nb = r % (NIN / 32), kb = r / (NIN / 32), n0 = 32 * nb; int orow0 = n0;
            float sc = 1.0f;
            if (n0 >= 8192) { const int c = n0 - 8192, hh = c >> 12, rem = c & 4095; orow0 = 8192 + (rem >> 7) * 256 + hh * 128 + (rem & 127); sc = -1.44269504089f; }
            p0_transpose_item(a.in[4], NIN, (bf16_t*)(a.ws + WS_WIN), DM, 0, 64 * kb, n0, orow0, scr, lane, sc, a.in[2]); return; } r -= I_IN;
        if (r < I_GLU) { const int nb = r % 128, kb = r / 128, n0 = 32 * nb, hh = n0 >> 11, rem = n0 & 2047, orow0 = (rem >> 7) * 256 + hh * 128 + (rem & 127);
            p0_transpose_item(a.in[13], 4096, (bf16_t*)(a.ws + WS_WGLU), 2048, 0, 64 * kb, n0, orow0, scr, lane); return; } r -= I_GLU;
        if (r < I_UP) { const int nb = r % 128, kb = r / 128; p0_transpose_item(a.in[15], 4096, (bf16_t*)(a.ws + WS_WUP), 4096, 0, 64 * kb, 32 * nb, 32 * nb, scr, lane); return; } r -= I_UP;
        if (r < I_UP) { const int nb = r % 128, kb = r / 128; p0_transpose_item(a.in[16], 4096, (bf16_t*)(a.ws + WS_WUP), 4096, 2048, 64 * kb, 32 * nb, 32 * nb, scr, lane); return; } r -= I_UP;
        { const int nb = r % 128, kb = r / 128; p0_transpose_item(a.in[17], 4096, (bf16_t*)(a.ws + WS_WOUT), 4096, 0, 64 * kb, 32 * nb, 32 * nb, scr, lane); }
}
__device__ __forceinline__ void p0_compute_part(const Args& a, const LAS f32x2* trig, int tid, int lane, int vcu, int gw, int NGW, int G) {
    for (int task = gw; task < 2048; task += NGW) p0_wfa_task(a.in[14], (bf16_t*)(a.ws + WS_WFA), trig, task, lane);
    const int gt = vcu * (NWAVES * 64) + tid, NT = G * NWAVES * 64;
    bf16_t* T2E = (bf16_t*)(a.ws + WS_T2E); bf16_t* T2O = (bf16_t*)(a.ws + WS_T2O); bf16_t* T4E = (bf16_t*)(a.ws + WS_T4E); bf16_t* T4O = (bf16_t*)(a.ws + WS_T4O);
    for (int q = gt; q < NP_ * (NP_ / 8); q += NT) { const int k = q >> 7, j0 = (q & 127) * 8; *(u32x4*)(T2E + (size_t)k * TLD + j0) = dft_piece<0>(k, j0, NP_, 0.02209708691f); *(u32x4*)(T2O + (size_t)k * TLD + j0) = dft_piece<1>(k, j0, NP_, 0.02209708691f); }
    for (int q = gt; q < NS_ * (NS_ / 8); q += NT) { const int k = q >> 8, j0 = (q & 255) * 8; *(u32x4*)(T4E + (size_t)k * TLD + j0) = dft_piece<0>(k, j0, NS_, 0.015625f); *(u32x4*)(T4O + (size_t)k * TLD + j0) = dft_piece<1>(k, j0, NS_, 0.015625f); }
}
__device__ __forceinline__ void p0_prologue(const Args& a, LAS unsigned char* lds, int tid, int lane, int wave, int vcu, int G) {
    for (int g = vcu; g < NG; g += G) p0_ssm_group(a, g, lds, tid);
    LAS f32x2* trig = (LAS f32x2*)(lds + XTRA_OFF);
    { const float fr = (float)tid * (1.0f / 512.0f); trig[tid] = (f32x2){__builtin_amdgcn_cosf(fr), __builtin_amdgcn_sinf(fr)}; }
    __syncthreads();
    const int gw = vcu * NWAVES + wave, NGW = G * NWAVES;
    int step = 0; const int cslot = wave * 5;
#define P0_STEP() do { if (step == cslot) p0_compute_part(a, trig, tid, lane, vcu, gw, NGW, G); ++step; } while (0)
    LAS float* scr = (LAS float*)(lds + RING_OFF + wave * 16384);
    const int NX = (G > NG) ? (G - NG) * NWAVES * 3 : 0;
    if (vcu >= NG) for (int it = (vcu - NG) * NWAVES + wave; it < NX; it += (G - NG) * NWAVES) { P0_STEP(); p0_transpose_dispatch(a, it, scr, lane); }
    for (int it = NX + gw; it < P0_NITEMS; it += NGW) { P0_STEP(); p0_transpose_dispatch(a, it, scr, lane); }
    for (int m = gw; m < M; m += NGW) { P0_STEP(); const float* xr = m < MP ? a.in[0] + (size_t)m * DM : a.in[1] + (size_t)(m - MP) * DM;
        rms_row_to_bf16(xr, (bf16_t*)(a.ws + WS_H) + (size_t)m * DM, (float*)(a.ws + WS_RMS) + m, lane); }
    if (step <= cslot) p0_compute_part(a, trig, tid, lane, vcu, gw, NGW, G);
#undef P0_STEP
}

__device__ __forceinline__ int xcd_remap(int L, int nwg) { const int q = nwg / 8, r = nwg % 8, x = L % 8, off = L / 8; return (x < r ? x * (q + 1) : r * (q + 1) + (x - r) * q) + off; }
template <int NSEG> struct TileSched {
    int nM, nN, nwg, G, c; const char* A0; const char* B0; const char* A1; const char* B1; size_t a_tile, b_tile; int nt0, nt1, flags0; int wgm = 8;
    __device__ __forceinline__ bool next(int i, gp::SU& u) const {
        const int ui = NSEG == 2 ? (i >> 1) : i, seg = NSEG == 2 ? (i & 1) : 0;
        const long L = (long)ui * G + c; if (L >= nwg) return false;
        const int wgid = xcd_remap((int)L, nwg);
        const int nig = wgm * nN, gid = wgid / nig, fm = gid * wgm, gsz = (nM - fm) < wgm ? (nM - fm) : wgm;
        u.pm = fm + ((wgid % nig) % gsz); u.pn = (wgid % nig) / gsz;
        u.A = (seg ? A1 : A0) + (size_t)u.pm * a_tile; u.B = (seg ? B1 : B0) + (size_t)u.pn * b_tile; u.nt = seg ? nt1 : nt0;
        u.flags = NSEG == 1 ? (gp::F_EPI | gp::F_ZERO) : (seg ? (gp::F_EPI | gp::F_ZERO | gp::F_SEG1) : flags0);
        return true; }
};
template <int NSEG> struct SsmSched {
    int G, c; const char* U; const char* E; const char* Bm; size_t b_group; int ksegB;
    __device__ __forceinline__ bool next(int i, gp::SU& u) const {
        const int ui = NSEG == 2 ? (i >> 1) : i, seg = NSEG == 2 ? (i & 1) : 0;
        const long L = (long)ui * G + c; if (L >= NG * 6) return false;
        const int wgid = xcd_remap((int)L, NG * 6), g = wgid / 6, ct = wgid % 6;
        u.pm = ct; u.pn = g; u.nt = 4;
        u.A = seg ? E + ((size_t)g * ESTR + (size_t)ct * 256) * 512 : U + ((size_t)g * NCH + (size_t)ct * 256) * 512; u.B = Bm + (size_t)g * b_group + (seg ? ksegB : 0);
        u.flags = NSEG == 1 ? (gp::F_EPI | gp::F_ZERO) : (seg ? (gp::F_EPI | gp::F_ZERO | gp::F_SEG1) : 0);
        return true; }
};
struct FaSched {
    int G, c; const char* A; const char* F;
    __device__ __forceinline__ bool next(int i, gp::SU& u) const {
        const long L = (long)i * G + c; if (L >= 8 * 96) return false;
        const int wgid = xcd_remap((int)L, 8 * 96), ct = wgid >> 3, rt = wgid & 7, g = rt >> 1, tk0 = ct * 256;
        int o, Hh; if (tk0 < MP) { o = tk0 & (LP - 1); Hh = LP / 4; } else { o = (tk0 - MP) & (LS - 1); Hh = LS / 4; }
        const int ab = (o / Hh) & 1;
        u.pm = rt; u.pn = ct; u.nt = 8;
        u.A = A + (size_t)(g * 1024 + ab * 512 + (rt & 1) * 256) * FGC * 2; u.B = F + (size_t)tk0 * 2048 * 2 + (size_t)g * FGC * 2;
        u.flags = gp::F_EPI | gp::F_ZERO; return true; }
};
struct FbSched {
    int G, c; const char* T2E; const char* T2O; const char* T4E; const char* T4O; const char* V;
    __device__ __forceinline__ bool next(int i, gp::SU& u) const {
        const long L = (long)i * G + c; if (L >= 768) return false;
        int rt, pn, tok0, N;
        if (L < 256) { const int x = (int)L & 7, j = (int)L >> 3; rt = (x & 3) * 4 + (j & 3); pn = j >> 2; tok0 = MP + (x >> 2) * LS; N = NS_; u.A = ((rt & 1) ? T4O : T4E) + (size_t)(rt >> 1) * 256 * TLD * 2; }
        else { const int q = (int)L - 256, ii = q >> 8, cc = q & 255, x = cc & 7, j = cc >> 3; rt = 4 * ii + (j & 3); pn = j >> 2; tok0 = x * LP; N = NP_; u.A = ((rt & 1) ? T2O : T2E) + (size_t)(rt >> 1) * 256 * TLD * 2; }
        const int par = rt & 1, kt = rt >> 1;
        u.nt = N / 64; u.B = V + ((size_t)pn * 256 * VLD + (size_t)tok0 + (size_t)par * N) * 2; u.pm = tok0 + 512 * kt + par; u.pn = pn;
        u.flags = gp::F_EPI | gp::F_ZERO; return true; }
};

typedef f32x4 AccT[2][2][4][2];
struct EpiG1 { bf16_t *U, *ZS, *UF, *ZF, *GT;
    __device__ __forceinline__ void operator()(AccT& acc, const gp::SU& u, int wr, int wc, int fr, int fq) const {
        const int pn = u.pn; const size_t row0 = (size_t)u.pm * 256;
        if (pn < 8) {
            bf16_t* base = U + ((size_t)(16 * pn) * M + row0) * 16;
            const unsigned lo = gp::opaque_u((unsigned)((2 * wc + (fq >> 1)) * M + wr * 64 + fr) * 16u + 8u * (unsigned)(fq & 1));
#pragma unroll
            for (int ai = 0; ai < 2; ++ai)
#pragma unroll
                for (int m = 0; m < 4; ++m)
#pragma unroll
                    for (int bj = 0; bj < 2; ++bj) *(u32x4*)(base + ((size_t)(8 * bj) * M + ai * 128 + m * 16) * 16 + lo) = gp::pack8(acc[ai][bj][m][0], acc[ai][bj][m][1]);
        } else if (pn < 16) {
            bf16_t* zb = ZS + ((size_t)u.pm * 8 + (pn - 8)) * 65536;
            const unsigned lo = gp::opaque_u((unsigned)((wr * 4 + wc) * 8192 + (fq * 16 + fr) * 8));
#pragma unroll
            for (int ai = 0; ai < 2; ++ai)
#pragma unroll
                for (int m = 0; m < 4; ++m)
#pragma unroll
                    for (int bj = 0; bj < 2; ++bj) *(u32x4*)(zb + (size_t)((ai * 4 + m) * 2 + bj) * 512 + lo) = gp::pack8(gp::act4<1>(acc[ai][bj][m][0]), gp::act4<1>(acc[ai][bj][m][1]));
        }
        else if (pn < 24) gp::store_tile<0>(acc, UF + row0 * 2048 + (pn - 16) * 256, 2048, wr, wc, fr, fq);
        else if (pn < 32) gp::store_tile<1>(acc, ZF + row0 * 2048 + (pn - 24) * 256, 2048, wr, wc, fr, fq);
        else {
            bf16_t* rb = GT + ((size_t)u.pm * 32 + (pn - 32)) * 32768; bf16_t* sb = rb + (size_t)M * 4096;
            const unsigned lo = gp::opaque_u((unsigned)((wr * 4 + wc) * 4096 + (fq * 16 + fr) * 8));
#pragma unroll
            for (int ai = 0; ai < 2; ++ai)
#pragma unroll
                for (int m = 0; m < 4; ++m) { const size_t off = (size_t)(ai * 4 + m) * 512; f32x4 rr[2], ss[2];
#pragma unroll
                    for (int n = 0; n < 2; ++n)
#pragma unroll
                        for (int k = 0; k < 4; ++k) { const float e0 = 1.0f + fminf(__builtin_amdgcn_exp2f(acc[ai][0][m][n][k]), 1e15f), e1 = 1.0f + fminf(__builtin_amdgcn_exp2f(acc[ai][1][m][n][k]), 1e15f);
                            const float ip = __builtin_amdgcn_rcpf(e0 * e1); ss[n][k] = e0 * ip; rr[n][k] = e1 * e1 * ip; }
                    *(u32x4*)(rb + off + lo) = gp::pack8(rr[0], rr[1]); *(u32x4*)(sb + off + lo) = gp::pack8(ss[0], ss[1]); }
        }
    }
};
struct EpiSS1 { bf16_t* E;
    __device__ __forceinline__ void operator()(AccT& acc, const gp::SU& u, int wr, int wc, int fr, int fq) const {
        gp::store_tile<0>(acc, E + ((size_t)u.pn * ESTR + (size_t)u.pm * 256) * 256, 256, wr, wc, fr, fq); }
};
struct EpiSS3 { bf16_t* YG;
    __device__ __forceinline__ void operator()(AccT& acc, const gp::SU& u, int wr, int wc, int fr, int fq) const {
        gp::store_tile<3>(acc, YG + ((size_t)u.pn * NCH + (size_t)u.pm * 256) * 256, 256, wr, wc, fr, fq); }
};
struct EpiFA { bf16_t* V;
    __device__ __forceinline__ void operator()(AccT& acc, const gp::SU& u, int wr, int wc, int fr, int fq) const {
        gp::store_tile<0>(acc, V + (size_t)u.pm * 256 * VLD + (size_t)u.pn * 256, VLD, wr, wc, fr, fq); }
};
struct EpiFB { const bf16_t* ZF; bf16_t* YF; const float* SPEC;
    __device__ __forceinline__ void operator()(AccT& acc, const gp::SU& u, int wr, int wc, int fr, int fq) const {
        const size_t t0 = (size_t)u.pm * 2048 + u.pn * 256; const bf16_t* zb = ZF + t0; bf16_t* yb = YF + t0;
        const unsigned lo = gp::opaque_u((unsigned)(wr * 64 + fr) * 4096u + (unsigned)(wc * 32 + 8 * fq));
        u32x4 z[2][4][2];
#pragma unroll
        for (int ai = 0; ai < 2; ++ai)
#pragma unroll
            for (int m = 0; m < 4; ++m)
#pragma unroll
                for (int bj = 0; bj < 2; ++bj) z[ai][m][bj] = *(const u32x4*)(zb + (size_t)(ai * 128 + m * 16) * 4096 + bj * 128 + lo);
        __builtin_amdgcn_sched_barrier(0);
        if ((u.pm & 1) == 0) { const int b = u.pm < MP ? (u.pm >> 11) : 8 + ((u.pm - MP) >> 12); const float sg = (fr & 1) ? -1.f : 1.f;
            const float* sp = SPEC + (size_t)b * 2048 + u.pn * 256 + gp::opaque_u((unsigned)(wc * 32 + 8 * fq));
#pragma unroll
            for (int bj = 0; bj < 2; ++bj) { const f32x4 s0 = *(const f32x4*)(sp + bj * 128) * sg, s1 = *(const f32x4*)(sp + bj * 128 + 4) * sg;
#pragma unroll
                for (int ai = 0; ai < 2; ++ai)
#pragma unroll
                    for (int m = 0; m < 4; ++m) { acc[ai][bj][m][0] += s0; acc[ai][bj][m][1] += s1; } } }
#pragma unroll
        for (int ai = 0; ai < 2; ++ai)
#pragma unroll
            for (int m = 0; m < 4; ++m) { const size_t off = (size_t)(ai * 128 + m * 16) * 4096;
#pragma unroll
                for (int bj = 0; bj < 2; ++bj) { f32x4 z0, z1; gp::unpack8(z[ai][m][bj], z0, z1);
                    *(u32x4*)(yb + off + bj * 128 + lo) = gp::pack8(acc[ai][bj][m][0] * z0, acc[ai][bj][m][1] * z1); } }
    }
};
struct EpiG2 { const bf16_t* ZS; bf16_t* YS;
    __device__ __forceinline__ void operator()(AccT& acc, const gp::SU& u, int wr, int wc, int fr, int fq) const {
        const size_t t0 = (size_t)u.pm * 256 * 2048 + u.pn * 128; bf16_t* yb = YS + t0;
        const bf16_t* zb = ZS + ((size_t)u.pm * 8 + (u.pn >> 1)) * 65536 + (size_t)(u.pn & 1) * 512;
        const unsigned lo = gp::opaque_u((unsigned)(wr * 64 + fr) * 2048u + (unsigned)(wc * 32 + 8 * fq));
        const unsigned lz = gp::opaque_u((unsigned)((wr * 4 + wc) * 8192 + (fq * 16 + fr) * 8));
        u32x4 z[2][4];
#pragma unroll
        for (int ai = 0; ai < 2; ++ai)
#pragma unroll
            for (int m = 0; m < 4; ++m) z[ai][m] = *(const u32x4*)(zb + (size_t)(ai * 4 + m) * 1024 + lz);
        __builtin_amdgcn_sched_barrier(0);
#pragma unroll
        for (int ai = 0; ai < 2; ++ai)
#pragma unroll
            for (int m = 0; m < 4; ++m) { const size_t off = (size_t)(ai * 128 + m * 16) * 2048;
                f32x4 z0, z1; gp::unpack8(z[ai][m], z0, z1);
                const f32x4 o0 = acc[ai][0][m][0] * gp::act4<2>(acc[ai][1][m][0]) * z0, o1 = acc[ai][0][m][1] * gp::act4<2>(acc[ai][1][m][1]) * z1;
                *(u32x4*)(yb + off + lo) = gp::pack8(o0, o1); }
    }
};
struct EpiG3 { const bf16_t* GT; bf16_t* MG;
    __device__ __forceinline__ void operator()(AccT& acc, const gp::SU& u, int wr, int wc, int fr, int fq) const {
        const bool fin = (u.flags & gp::F_SEG1) != 0; const size_t t0 = (size_t)u.pm * 256 * 4096 + u.pn * 256;
        const bf16_t* gb = GT + ((size_t)u.pm * 32 + 2 * u.pn) * 32768 + (fin ? (size_t)M * 4096 : (size_t)0); bf16_t* mb = MG + t0;
        const unsigned lo = gp::opaque_u((unsigned)(wr * 64 + fr) * 4096u + (unsigned)(wc * 32 + 8 * fq));
        const unsigned lg = gp::opaque_u((unsigned)((wr * 4 + wc) * 4096 + (fq * 16 + fr) * 8));
        u32x4 gw[2][4][2];
#pragma unroll
        for (int ai = 0; ai < 2; ++ai)
#pragma unroll
            for (int m = 0; m < 4; ++m)
#pragma unroll
                for (int bj = 0; bj < 2; ++bj) gw[ai][m][bj] = *(const u32x4*)(gb + (size_t)bj * 32768 + (size_t)(ai * 4 + m) * 512 + lg);
        __builtin_amdgcn_sched_barrier(0);
#pragma unroll
        for (int ai = 0; ai < 2; ++ai)
#pragma unroll
            for (int m = 0; m < 4; ++m)
#pragma unroll
                for (int bj = 0; bj < 2; ++bj) { f32x4 g0, g1; gp::unpack8(gw[ai][m][bj], g0, g1);
                    if (!fin) { acc[ai][bj][m][0] *= g0; acc[ai][bj][m][1] *= g1; }
                    else *(u32x4*)(mb + (size_t)(ai * 128 + m * 16) * 4096 + bj * 128 + lo) = gp::pack8(acc[ai][bj][m][0] * g0, acc[ai][bj][m][1] * g1); }
    }
};
struct EpiG4 { bf16_t* O;
    __device__ __forceinline__ void operator()(AccT& acc, const gp::SU& u, int wr, int wc, int fr, int fq) const {
        gp::store_tile<0>(acc, O + (size_t)u.pm * 256 * 4096 + u.pn * 256, 4096, wr, wc, fr, fq); }
};

template <int SGN> __device__ __forceinline__ void ss2_scan_dir(unsigned* E32, const f32x2* LT, int g, int chunk0, int nc, int lane) {
    constexpr int D = 64; constexpr int dir = SGN > 0 ? 0 : 1;
    unsigned* p = E32 + ((size_t)g * ESTR + chunk0 + (dir ? nc - 1 : 0)) * 128 + dir * 64;
    const f32x2 lt = LT[(g * 2 + dir) * 64 + lane];
    float sr = 0.f, si = 0.f;
    for (int kk = 0; kk < nc; kk += D) {
        unsigned v[D];
#pragma unroll
        for (int j = 0; j < D; ++j) v[j] = p[SGN * j * 128 + lane];
        __builtin_amdgcn_sched_barrier(0);
#pragma unroll
        for (int j = 0; j < D; ++j) {
            p[SGN * j * 128 + lane] = pk2(sr, si);
            const float er = gp::bf_lo(v[j]), ei = gp::bf_hi(v[j]);
            const float nr = lt.x * sr - lt.y * si + er, ni = lt.x * si + lt.y * sr + ei; sr = nr; si = ni; }
        p += SGN * D * 128;
    }
}
__device__ __forceinline__ void ss2_scan(unsigned* E32, const f32x2* LT, int g, int dir, int chunk0, int nc, int lane) {
    if (dir == 0) ss2_scan_dir<1>(E32, LT, g, chunk0, nc, lane); else ss2_scan_dir<-1>(E32, LT, g, chunk0, nc, lane);
}
__device__ __forceinline__ void fold_task(const bf16_t* UF, bf16_t* F, bf16_t* XH, int t, int lane) {
    int b, n, L, tok0; if (t < 8 * (LP / 4)) { b = t >> 9; n = t & 511; L = LP; tok0 = b * LP; } else { const int q = t - 8 * (LP / 4); b = 8 + (q >> 10); n = q & 1023; L = LS; tok0 = MP + (q >> 10) * LS; }
    const int N = L >> 1, H = L >> 2;
    const int i0 = n, i1 = n + N, i2 = n ? N - n : H, i3 = n ? 2 * N - n : H + N;
    const u32x4* r0 = (const u32x4*)(UF + (size_t)(tok0 + i0) * 2048) + lane; const u32x4* r1 = (const u32x4*)(UF + (size_t)(tok0 + i1) * 2048) + lane;
    const u32x4* r2 = (const u32x4*)(UF + (size_t)(tok0 + i2) * 2048) + lane; const u32x4* r3 = (const u32x4*)(UF + (size_t)(tok0 + i3) * 2048) + lane;
    u32x4* o0 = (u32x4*)(F + (size_t)(tok0 + n) * 2048) + lane; u32x4* o1 = (u32x4*)(F + (size_t)(tok0 + H + n) * 2048) + lane;
    u32x4* o2 = (u32x4*)(F + (size_t)(tok0 + N + n) * 2048) + lane; u32x4* o3 = (u32x4*)(F + (size_t)(tok0 + N + H + n) * 2048) + lane;
    u32x4* ox = (u32x4*)(XH + (size_t)b * 2048) + lane;
#pragma unroll
    for (int i = 0; i < 4; ++i) { f32x4 a0, a1, b0, b1, c0, c1, d0, d1;
        gp::unpack8(r0[64 * i], a0, a1); gp::unpack8(r1[64 * i], b0, b1); gp::unpack8(r2[64 * i], c0, c1); gp::unpack8(r3[64 * i], d0, d1);
        const f32x4 p0 = a0 + b0, p1 = a1 + b1, q0 = a0 - b0, q1 = a1 - b1, pm0 = c0 + d0, pm1 = c1 + d1, qm0 = c0 - d0, qm1 = c1 - d1;
        if (n) { o0[64 * i] = gp::pack8(p0 + pm0, p1 + pm1); o1[64 * i] = gp::pack8(p0 - pm0, p1 - pm1); o2[64 * i] = gp::pack8(q0 - qm0, q1 - qm1); o3[64 * i] = gp::pack8(q0 + qm0, q1 + qm1); }
        else { o0[64 * i] = gp::pack8(p0, p1); o1[64 * i] = (u32x4){0u, 0u, 0u, 0u}; o2[64 * i] = gp::pack8(q0, q1); o3[64 * i] = gp::pack8(qm0, qm1); ox[64 * i] = gp::pack8(pm0, pm1); } }
}
__device__ __forceinline__ void spec_wave(const bf16_t* WFA, const bf16_t* XH, float* SPEC, int ch, int lane) {
    const int g = ch >> 9, d = ch & 511;
    f32x4 w0, w1; gp::unpack8(*((const u32x4*)(WFA + (size_t)(g * 1024 + d) * FGC) + lane), w0, w1);
    u32x4 xv[10];
#pragma unroll
    for (int b = 0; b < 10; ++b) xv[b] = *((const u32x4*)(XH + (size_t)b * 2048 + g * FGC) + lane);
    float res = 0.f;
#pragma unroll
    for (int b = 0; b < 10; ++b) { f32x4 x0, x1; gp::unpack8(xv[b], x0, x1);
        float s = (w0[0] * x0[0] + w0[1] * x0[1]) + (w0[2] * x0[2] + w0[3] * x0[3]) + (w1[0] * x1[0] + w1[1] * x1[1]) + (w1[2] * x1[2] + w1[3] * x1[3]);
        s = wave_sum(s) * (b < 8 ? 0.02209708691f : 0.015625f);
        if (lane == b) res = s; }
    if (lane < 10) SPEC[(size_t)lane * 2048 + ch] = res;
}
__device__ __forceinline__ void final_row(const bf16_t* orow, const bf16_t* hrow, float rms_pre, const float* gain, float* yrow, int lane) {
    const u32x4* o16 = (const u32x4*)orow + lane; const u32x4* h16 = (const u32x4*)hrow + lane; u32x4 ov[8], hv[8]; float s = 0.f;
#pragma unroll
    for (int j = 0; j < 8; ++j) { ov[j] = o16[64 * j]; hv[j] = h16[64 * j]; }
#pragma unroll
    for (int j = 0; j < 8; ++j) { f32x4 a, b; gp::unpack8(ov[j], a, b); s += (a.x * a.x + a.y * a.y) + (a.z * a.z + a.w * a.w) + (b.x * b.x + b.y * b.y) + (b.z * b.z + b.w * b.w); }
    const float r = 1.0f / sqrtf(wave_sum(s) * (1.f / DM) + RMS_EPS);
#pragma unroll
    for (int j = 0; j < 8; ++j) { f32x4 a, b, x0, x1; gp::unpack8(ov[j], a, b); gp::unpack8(hv[j], x0, x1); const size_t e0 = (size_t)(lane + 64 * j) * 8;
        const f32x4 g0 = *(const f32x4*)(gain + e0), g1 = *(const f32x4*)(gain + e0 + 4);
        *(f32x4*)(yrow + e0) = x0 * rms_pre + a * r * g0; *(f32x4*)(yrow + e0 + 4) = x1 * rms_pre + b * r * g1; }
}

#ifndef MK_N_LAUNCHES
#define MK_N_LAUNCHES 1
#endif
constexpr int N_PHASES = 9;
constexpr bool ONE_LAUNCH = (MK_N_LAUNCHES == 1);
#ifndef PG8_SP2
#define PG8_SP2 true
#endif
#ifndef PG8_ALIGN
#define PG8_ALIGN true
#endif

__global__ void __launch_bounds__(NWAVES * 64, 2) hybrid_fwd(Args args) {
    extern __shared__ __attribute__((aligned(16))) unsigned char lds_raw[];
    LAS unsigned char* lds = (LAS unsigned char*)lds_raw;
    volatile LAS unsigned* MISC = (volatile LAS unsigned*)(lds + MISC_OFF);
    const int tid = threadIdx.x, lane = tid & 63, wave = __builtin_amdgcn_readfirstlane(tid >> 6);
    const int G = gridDim.x; const int bx = blockIdx.x; const int vcu = (G % 8 == 0) ? (bx % 8) * (G / 8) + bx / 8 : bx;
    unsigned char* ws = args.ws;
    unsigned* ctl = (unsigned*)(ws + WS_CTL);
    for (int u = tid; u < 512 / 4; u += NWAVES * 64) ((LAS unsigned*)(lds + MISC_OFF))[u] = 0u;
    __syncthreads();
    XcdBarrier bar; bar.bar = ctl + CW_BAR; bar.x = 0; bar.st = nullptr;
    if (ONE_LAUNCH) bar = xcd_barrier_post(ctl + CW_BAR, MISC + 8);
#define GRID_BAR() do { if (ONE_LAUNCH) xcd_barrier(bar); } while (0)
    const int lo = args.ph_lo, hi = args.ph_hi;
#define IN(k) (lo <= (k) && (k) < hi)
#define BOTH(k) (IN(k) && IN((k) + 1))

    if (IN(0)) { p0_prologue(args, lds, tid, lane, wave, vcu, G); if (BOTH(0)) GRID_BAR(); }

    if (IN(1)) {
        TileSched<1> S; S.nM = M / 256; S.nN = NIN / 256; S.nwg = S.nM * S.nN; S.G = G; S.c = bx;
        S.wgm = 4;
        S.A0 = (const char*)(ws + WS_H); S.B0 = (const char*)(ws + WS_WIN); S.A1 = S.A0; S.B1 = S.B0; S.a_tile = (size_t)256 * DM * 2; S.b_tile = (size_t)256 * DM * 2; S.nt0 = DM / 64; S.nt1 = 0; S.flags0 = 0;
        EpiG1 E{(bf16_t*)(ws + WS_U), (bf16_t*)(ws + WS_ZS), (bf16_t*)(ws + WS_UF), (bf16_t*)(ws + WS_ZF), (bf16_t*)args.out};
                gp::gemm_phase<gp::RowMajor, gp::RowMajor, TileSched<1>, EpiG1, PG8_ALIGN, PG8_SP2>(lds + RING_OFF, gp::RowMajor{DM}, gp::RowMajor{DM}, S, E);
        if (BOTH(1)) GRID_BAR();
    }

    if (IN(2)) {
        { SsmSched<1> S; S.G = G; S.c = bx; S.U = (const char*)(ws + WS_U); S.E = S.U; S.Bm = (const char*)(ws + WS_ME); S.b_group = (size_t)256 * 256 * 2; S.ksegB = 0;
          EpiSS1 E{(bf16_t*)(ws + WS_E)};
          gp::gemm_phase<gp::RowMajor, gp::RowMajor, SsmSched<1>, EpiSS1, PG8_ALIGN, PG8_SP2>(lds + RING_OFF, gp::RowMajor{256}, gp::RowMajor{256}, S, E); }
        { unsigned* E32 = (unsigned*)(ws + WS_E); const f32x2* LT = (const f32x2*)(ws + WS_LT); int idx = 0;
          for (int i = 0; ; ++i) { const long L = (long)i * G + bx; if (L >= NG * 6) break;
              const int wgid = xcd_remap((int)L, NG * 6), g = wgid / 6, ct = wgid % 6, ntk = ct < 4 ? 4 : 2;
              for (int k = 0; k < ntk; ++k, ++idx) if ((idx & 7) == wave) {
                  if (ct < 4) ss2_scan(E32, LT, g, k & 1, (2 * ct + (k >> 1)) * (LP / TCH), LP / TCH, lane);
                  else ss2_scan(E32, LT, g, k & 1, (MP / TCH) + (ct - 4) * (LS / TCH), LS / TCH, lane); } } }
        { const int gw = vcu * NWAVES + wave, NGW = G * NWAVES;
          for (int t = gw; t < 8 * (LP / 4) + 2 * (LS / 4); t += NGW) fold_task((const bf16_t*)(ws + WS_UF), (bf16_t*)(ws + WS_F), (bf16_t*)(ws + WS_XH), t, lane); }
        if (BOTH(2)) GRID_BAR();
    }

    if (IN(3)) {
        for (int ch = vcu * NWAVES + wave; ch < 2048; ch += G * NWAVES) spec_wave((const bf16_t*)(ws + WS_WFA), (const bf16_t*)(ws + WS_XH), (float*)(ws + WS_SPEC), ch, lane);
        __syncthreads();
        { FaSched S; S.G = G; S.c = bx; S.A = (const char*)(ws + WS_WFA); S.F = (const char*)(ws + WS_F);
          EpiFA E{(bf16_t*)(ws + WS_V)};
          gp::gemm_phase<gp::RowMajor, gp::RowMajor, FaSched, EpiFA, PG8_ALIGN, PG8_SP2>(lds + RING_OFF, gp::RowMajor{FGC}, gp::RowMajor{2048}, S, E); }
        if (BOTH(3)) GRID_BAR();
    }

    if (IN(4)) {
        { FbSched S; S.G = G; S.c = bx; S.T2E = (const char*)(ws + WS_T2E); S.T2O = (const char*)(ws + WS_T2O); S.T4E = (const char*)(ws + WS_T4E); S.T4O = (const char*)(ws + WS_T4O); S.V = (const char*)(ws + WS_V);
          EpiFB E{(const bf16_t*)(ws + WS_ZF), (bf16_t*)(ws + WS_YF), (const float*)(ws + WS_SPEC)};
          gp::gemm_phase<gp::RowMajor, gp::RowMajor, FbSched, EpiFB, PG8_ALIGN, PG8_SP2>(lds + RING_OFF, gp::RowMajor{TLD}, gp::RowMajor{VLD}, S, E); }
        { SsmSched<2> S; S.G = G; S.c = bx; S.U = (const char*)(ws + WS_U); S.E = (const char*)(ws + WS_E); S.Bm = (const char*)(ws + WS_MTF); S.b_group = (size_t)256 * 512 * 2; S.ksegB = 256 * 2;
          EpiSS3 E{(bf16_t*)(ws + WS_YG)};
          gp::gemm_phase<gp::RowMajor, gp::RowMajor, SsmSched<2>, EpiSS3, PG8_ALIGN, PG8_SP2>(lds + RING_OFF, gp::RowMajor{256}, gp::RowMajor{512}, S, E); }
        if (BOTH(4)) GRID_BAR();
    }

    if (IN(5)) {
        TileSched<1> S; S.nM = M / 256; S.nN = 4096 / 256; S.nwg = S.nM * S.nN; S.G = G; S.c = bx;
        S.A0 = (const char*)(ws + WS_YG); S.B0 = (const char*)(ws + WS_WGLU); S.A1 = S.A0; S.B1 = S.B0; S.a_tile = (size_t)256 * 32; S.b_tile = (size_t)256 * 2048 * 2; S.nt0 = 2048 / 64; S.nt1 = 0; S.flags0 = 0;
        EpiG2 E{(const bf16_t*)(ws + WS_ZS), (bf16_t*)(ws + WS_YS)};
        gp::gemm_phase<gp::GroupMajor, gp::RowMajor, TileSched<1>, EpiG2, PG8_ALIGN, PG8_SP2>(lds + RING_OFF, gp::GroupMajor{M}, gp::RowMajor{2048}, S, E);
        if (BOTH(5)) GRID_BAR();
    }

    if (IN(6)) {
        TileSched<2> S; S.nM = M / 256; S.nN = DM / 256; S.nwg = S.nM * S.nN; S.G = G; S.c = bx;
        S.A0 = (const char*)(ws + WS_YS); S.A1 = (const char*)(ws + WS_YF); S.B0 = (const char*)(ws + WS_WUP); S.B1 = S.B0 + 2048 * 2;
        S.a_tile = (size_t)256 * 2048 * 2; S.b_tile = (size_t)256 * 4096 * 2; S.nt0 = 2048 / 64; S.nt1 = 2048 / 64; S.flags0 = gp::F_EPI;
        EpiG3 E{(const bf16_t*)args.out, (bf16_t*)(ws + WS_MG)};
        gp::gemm_phase<gp::RowMajor, gp::RowMajor, TileSched<2>, EpiG3, PG8_ALIGN, PG8_SP2>(lds + RING_OFF, gp::RowMajor{2048}, gp::RowMajor{4096}, S, E);
        if (BOTH(6)) GRID_BAR();
    }

    if (IN(7)) {
        TileSched<1> S; S.nM = M / 256; S.nN = DM / 256; S.nwg = S.nM * S.nN; S.G = G; S.c = bx;
        S.A0 = (const char*)(ws + WS_MG); S.B0 = (const char*)(ws + WS_WOUT); S.A1 = S.A0; S.B1 = S.B0; S.a_tile = (size_t)256 * DM * 2; S.b_tile = (size_t)256 * DM * 2; S.nt0 = DM / 64; S.nt1 = 0; S.flags0 = 0;
        EpiG4 E{(bf16_t*)(ws + WS_OUTB)};
        gp::gemm_phase<gp::RowMajor, gp::RowMajor, TileSched<1>, EpiG4, PG8_ALIGN, PG8_SP2>(lds + RING_OFF, gp::RowMajor{DM}, gp::RowMajor{DM}, S, E);
        if (BOTH(7)) GRID_BAR();
    }

    if (IN(8)) {
        const int gw = vcu * NWAVES + wave, NGW = G * NWAVES;
        for (int m = gw; m < M; m += NGW)
            final_row((const bf16_t*)(ws + WS_OUTB) + (size_t)m * DM, (const bf16_t*)(ws + WS_H) + (size_t)m * DM, ((const float*)(ws + WS_RMS))[m], args.in[3], args.out + (size_t)m * DM, lane);
    }
#undef IN
#undef BOTH
#undef GRID_BAR
}


extern "C" void kernel_launch(void* const* d_in, const int* in_sizes, int n_in, void* d_out, int out_size, void* d_ws, size_t ws_size, hipStream_t stream) {
    static int grid = 0;
    if (grid == 0) {
        if (n_in != 18 || out_size != M * DM || ws_size < WS_END) { fprintf(stderr, "kernel_launch: built for 18 inputs, %d outputs, >= %zu bytes of workspace; got n_in %d, out %d, ws %zu; nothing launched\n", M * DM, (size_t)WS_END, n_in, out_size, ws_size); grid = -1; return; }
        int dev = 0, cus = 0, per_cu = 0;
        if (hipGetDevice(&dev) != hipSuccess || hipDeviceGetAttribute(&cus, hipDeviceAttributeMultiprocessorCount, dev) != hipSuccess) { fprintf(stderr, "kernel_launch: hipGetDevice / hipDeviceGetAttribute failed\n"); grid = -1; return; }
        if (hipFuncSetAttribute((const void*)hybrid_fwd, hipFuncAttributeMaxDynamicSharedMemorySize, LDS_BYTES) != hipSuccess) { fprintf(stderr, "kernel_launch: hipFuncSetAttribute failed\n"); grid = -1; return; }
        if (hipOccupancyMaxActiveBlocksPerMultiprocessor(&per_cu, (const void*)hybrid_fwd, NWAVES * 64, LDS_BYTES) != hipSuccess || per_cu < 1)
            fprintf(stderr, "kernel_launch: note: occupancy query reports %d workgroups per CU\n", per_cu);
        (void)hipGetLastError();
        grid = cus;
    }
    if (grid < 0) return;
    if (hipMemsetAsync((char*)d_ws + WS_CTL, 0, CTL_ZERO_BYTES, stream) != hipSuccess) { fprintf(stderr, "kernel_launch: hipMemsetAsync failed\n"); return; }
    Args a{};
    for (int i = 0; i < 18; ++i) a.in[i] = (const float*)d_in[i];
    a.out = (float*)d_out; a.ws = (unsigned char*)d_ws;
    if (MK_N_LAUNCHES == 1) { a.ph_lo = 0; a.ph_hi = N_PHASES; hipLaunchKernelGGL(hybrid_fwd, dim3(grid), dim3(NWAVES * 64), LDS_BYTES, stream, a); }
    else for (int p = 0; p < N_PHASES; ++p) { a.ph_lo = p; a.ph_hi = p + 1; hipLaunchKernelGGL(hybrid_fwd, dim3(grid), dim3(NWAVES * 64), LDS_BYTES, stream, a);
    }
    const hipError_t le = hipPeekAtLastError();
    if (le != hipSuccess) fprintf(stderr, "kernel_launch: launch failed: %s\n", hipGetErrorName(le));
}
```
